# Optimizing an MI355X kernel written in HIP

```python
import jax, jax.numpy as jnp
from jax import lax
import numpy as np

D_MODEL = 1024
BATCH = 4
SEQ = 4096
DEPTH = 1

N_MEM = 256
MIX_WIDTH = D_MODEL
FOX_HEADS = 8
FOX_HEAD_DIM = 64
FOX_WIDTH = FOX_HEADS * FOX_HEAD_DIM
GMLP_GROUPS = 8
GMLP_GROUP_DIM = 64
GMLP_WIDTH = GMLP_GROUPS * GMLP_GROUP_DIM
CHUNK = 128
Q_BLOCK = 128
Q_OFF = 0
K_OFF = Q_OFF + FOX_WIDTH
V_OFF = K_OFF + FOX_WIDTH
F_OFF = V_OFF + FOX_WIDTH
UV_OFF = F_OFF + FOX_HEADS
IN_COLS = UV_OFF + 2 * GMLP_WIDTH
CA_HEADS = 4
CA_HEAD_DIM = D_MODEL // CA_HEADS
D_FF = 2816
EPS = 1e-6

kernel_name = "hybrid_fox_gmlp_macaron_memxattn"


def rms_norm(x, g):
    xf = x.astype(jnp.float32)
    y = xf * lax.rsqrt(jnp.mean(xf * xf, axis=-1, keepdims=True) + EPS)
    return (y * g.astype(jnp.float32)).astype(x.dtype)


def swiglu(h, w_in, w_out):
    gu = h @ w_in
    g, u = jnp.split(gu, 2, axis=-1)
    return (jax.nn.silu(g) * u) @ w_out


def fox_attention(q, k, v, log_f):
    S = q.shape[2]
    scale = FOX_HEAD_DIM ** -0.5
    c = jnp.cumsum(log_f, axis=-1)
    neg = jnp.finfo(jnp.float32).min
    outs = []
    for i in range(S // Q_BLOCK):
        q0, q1 = i * Q_BLOCK, (i + 1) * Q_BLOCK
        qb, kb, vb = q[:, :, q0:q1], k[:, :, :q1], v[:, :, :q1]
        s = (jnp.einsum('bhqd,bhkd->bhqk', qb, kb).astype(jnp.float32) * scale
             + c[:, :, q0:q1, None] - c[:, :, None, :q1])
        mask = (q0 + jnp.arange(Q_BLOCK))[:, None] >= jnp.arange(q1)[None, :]
        s = jnp.where(mask, s, neg)
        p = jax.nn.softmax(s, axis=-1)
        outs.append(jnp.einsum('bhqk,bhkd->bhqd', p.astype(vb.dtype), vb))
    return jnp.concatenate(outs, axis=2)


def spatial_gating(u, v, w_s, b_s):
    B, S, G, Dg = v.shape
    vc = v.reshape(B, S // CHUNK, CHUNK, G, Dg)
    tril = jnp.tril(jnp.ones((CHUNK, CHUNK), dtype=bool))
    w = jnp.where(tril[None], w_s, jnp.zeros_like(w_s))
    mixed = jnp.einsum('gts,bcsgd->bctgd', w, vc) + b_s.T[None, None, :, :, None]
    return u * mixed.reshape(B, S, G, Dg)


def mem_cross_attention(h, m, w_cq, w_ckv, g_cq, g_ck, w_co):
    B, S, _ = h.shape
    M = m.shape[1]
    q = (h @ w_cq).reshape(B, S, CA_HEADS, CA_HEAD_DIM)
    kv = m @ w_ckv
    k, v = jnp.split(kv, 2, axis=-1)
    k = k.reshape(B, M, CA_HEADS, CA_HEAD_DIM)
    v = v.reshape(B, M, CA_HEADS, CA_HEAD_DIM)
    q = rms_norm(q, g_cq)
    k = rms_norm(k, g_ck)
    s = jnp.einsum('bqhd,bkhd->bhqk', q, k).astype(jnp.float32) * (CA_HEAD_DIM ** -0.5)
    p = jax.nn.softmax(s, axis=-1)
    o = jnp.einsum('bhqk,bkhd->bqhd', p.astype(v.dtype), v).reshape(B, S, D_MODEL)
    return o @ w_co


def setup_inputs(seed: int = 0) -> dict:
    key = jax.random.key(seed)
    ks = jax.random.split(key, 32)
    L = DEPTH

    def w(k, shape, fan_in):
        return jax.random.normal(k, shape, jnp.float32) * (fan_in ** -0.5)

    def g(k, shape):
        return 1.0 + 0.02 * jax.random.normal(k, shape, jnp.float32)

    b_f = (jnp.linspace(1.0, 6.0, FOX_HEADS, dtype=jnp.float32)[None, :]
           + 0.1 * jax.random.normal(ks[7], (L, FOX_HEADS), jnp.float32))
    return {
        "x": jax.random.normal(ks[0], (BATCH, SEQ, D_MODEL), jnp.float32),
        "mem": jax.random.normal(ks[1], (BATCH, N_MEM, D_MODEL), jnp.float32),
        "g_ffn1": g(ks[2], (L, D_MODEL)),
        "w_ffn1_in": w(ks[3], (L, D_MODEL, 2 * D_FF), D_MODEL),
        "w_ffn1_out": w(ks[4], (L, D_FF, D_MODEL), D_FF),
        "g_mix": g(ks[5], (L, D_MODEL)),
        "w_in": w(ks[6], (L, D_MODEL, IN_COLS), D_MODEL),
        "b_f": b_f,
        "g_q": g(ks[8], (L, FOX_HEAD_DIM)),
        "g_k": g(ks[9], (L, FOX_HEAD_DIM)),
        "g_sgu": g(ks[10], (L, GMLP_WIDTH)),
        "w_s": w(ks[11], (L, GMLP_GROUPS, CHUNK, CHUNK), CHUNK),
        "b_s": g(ks[12], (L, GMLP_GROUPS, CHUNK)),
        "g_fox_o": g(ks[13], (L, FOX_WIDTH)),
        "g_gmlp_o": g(ks[14], (L, GMLP_WIDTH)),
        "w_out": w(ks[15], (L, MIX_WIDTH, D_MODEL), MIX_WIDTH),
        "g_ca": g(ks[16], (L, D_MODEL)),
        "g_mem": g(ks[17], (L, D_MODEL)),
        "w_cq": w(ks[18], (L, D_MODEL, D_MODEL), D_MODEL),
        "w_ckv": w(ks[19], (L, D_MODEL, 2 * D_MODEL), D_MODEL),
        "g_cq": g(ks[20], (L, CA_HEAD_DIM)),
        "g_ck": g(ks[21], (L, CA_HEAD_DIM)),
        "w_co": w(ks[22], (L, D_MODEL, D_MODEL), D_MODEL),
        "g_ffn2": g(ks[23], (L, D_MODEL)),
        "w_ffn2_in": w(ks[24], (L, D_MODEL, 2 * D_FF), D_MODEL),
        "w_ffn2_out": w(ks[25], (L, D_FF, D_MODEL), D_FF),
    }


def reference(x, mem, g_ffn1, w_ffn1_in, w_ffn1_out, g_mix, w_in, b_f, g_q, g_k,
              g_sgu, w_s, b_s, g_fox_o, g_gmlp_o, w_out, g_ca, g_mem, w_cq, w_ckv,
              g_cq, g_ck, w_co, g_ffn2, w_ffn2_in, w_ffn2_out):
    B, S, _ = x.shape
    for l in range(DEPTH):
        x = x + 0.5 * swiglu(rms_norm(x, g_ffn1[l]), w_ffn1_in[l], w_ffn1_out[l])

        h = rms_norm(x, g_mix[l])
        z = h @ w_in[l]
        q = z[..., Q_OFF:K_OFF].reshape(B, S, FOX_HEADS, FOX_HEAD_DIM)
        k = z[..., K_OFF:V_OFF].reshape(B, S, FOX_HEADS, FOX_HEAD_DIM)
        v = z[..., V_OFF:F_OFF].reshape(B, S, FOX_HEADS, FOX_HEAD_DIM)
        f_logit = z[..., F_OFF:UV_OFF]
        uv = z[..., UV_OFF:]

        q = rms_norm(q, g_q[l])
        k = rms_norm(k, g_k[l])
        log_f = jax.nn.log_sigmoid(f_logit.astype(jnp.float32) + b_f[l].astype(jnp.float32))
        attn = fox_attention(q.transpose(0, 2, 1, 3), k.transpose(0, 2, 1, 3),
                             v.transpose(0, 2, 1, 3), log_f.transpose(0, 2, 1))
        attn = attn.transpose(0, 2, 1, 3).reshape(B, S, FOX_WIDTH)

        uv = jax.nn.gelu(uv)
        u, vg = jnp.split(uv, 2, axis=-1)
        vg = rms_norm(vg, g_sgu[l])
        sgu = spatial_gating(u.reshape(B, S, GMLP_GROUPS, GMLP_GROUP_DIM),
                             vg.reshape(B, S, GMLP_GROUPS, GMLP_GROUP_DIM),
                             w_s[l], b_s[l]).reshape(B, S, GMLP_WIDTH)

        y = jnp.concatenate([rms_norm(attn, g_fox_o[l]), rms_norm(sgu, g_gmlp_o[l])], axis=-1)
        x = x + y @ w_out[l]

        x = x + mem_cross_attention(rms_norm(x, g_ca[l]), rms_norm(mem, g_mem[l]),
                                    w_cq[l], w_ckv[l], g_cq[l], g_ck[l], w_co[l])

        x = x + 0.5 * swiglu(rms_norm(x, g_ffn2[l]), w_ffn2_in[l], w_ffn2_out[l])
    return x
```

```cpp
#include <hip/hip_runtime.h>
#include <hip/hip_bf16.h>
#include <cstdio>
#include <cstdint>
#include <cmath>
namespace pg8 {
#define PG8_LAS __attribute__((address_space(3)))
typedef unsigned short bf16_t;
typedef short bf16x8 __attribute__((ext_vector_type(8)));
typedef float f32x4 __attribute__((ext_vector_type(4)));
typedef unsigned u32x4 __attribute__((ext_vector_type(4)));
constexpr int BM = 256, BK = 64, HALF = 128, HTB = HALF * BK * 2  , STAGE_BYTES = 8 * HTB, NXCD = 8, WGM = 8;

__host__ __device__ __forceinline__ int lds_byte(int r, int c) { const int st = (r >> 4) * 2 + (c >> 5), rr = r & 15, cc = c & 31, ob = rr * 64 + cc * 2; return st * 1024 + (ob ^ (((ob >> 9) & 1) << 5)); }
__host__ __device__ __forceinline__ void stage_rc(int b, int& R, int& C) { const int st = b / 1024, sb = b % 1024, swz = sb ^ (((sb >> 9) & 1) << 5); R = (st >> 1) * 16 + swz / 64; C = (st & 1) * 32 + (swz % 64) / 2; }
__host__ __device__ __forceinline__ int perm32(int rho) { const int n = rho >> 4, i = rho & 15; return 8 * (i >> 2) + 4 * n + (i & 3); }

struct Unit { int pm, pn; };
struct Gemm { const bf16_t* A; const bf16_t* Bt; int M, N, K; };

struct StaticOrder {
    int nM, nN, nwg, G, c;
    __host__ __device__ void init(int M, int N, int G_, int c_) { nM = M / BM; nN = N / BM; nwg = nM * nN; G = G_; c = c_; }
    __host__ __device__ bool next(int i, Unit& u) const {
        const long L = (long)i * G + c; if (L >= nwg) return false;
        int wgid = (int)L; { const int q = nwg / NXCD, r = nwg % NXCD, xcd = wgid % NXCD, off = wgid / NXCD; wgid = (xcd < r ? xcd * (q + 1) : r * (q + 1) + (xcd - r) * q) + off; }
        const int nig = WGM * nN, gid = wgid / nig, fm = gid * WGM, gsz = (nM - fm) < WGM ? (nM - fm) : WGM;
        u.pm = fm + ((wgid % nig) % gsz); u.pn = (wgid % nig) / gsz; return true;
    }
    __device__ __forceinline__ void a_ready(const Unit&) const {}
    __device__ __forceinline__ void done(const Unit&) const {}
};

__device__ __forceinline__ unsigned cvt_pk_bf16(float lo, float hi) { unsigned r; asm volatile("v_cvt_pk_bf16_f32 %0, %1, %2" : "=v"(r) : "v"(lo), "v"(hi)); return r; }
typedef float f32x2 __attribute__((ext_vector_type(2)));
__device__ __forceinline__ f32x2 gelu_pk(f32x2 v) {
    const f32x2 av = __builtin_elementwise_abs(v), d = av * 0.2316418882f + 1.0f;
    f32x2 t; t.x = __builtin_amdgcn_rcpf(d.x); t.y = __builtin_amdgcn_rcpf(d.y);
    f32x2 q = t * 0.5307027145f + (-0.7265760135f); q = q * t + 0.7107068705f; q = q * t + (-0.142248368f); q = q * t + 0.127414796f; q = q * t;
    const f32x2 s = (v * v) * (-0.72134752044f);
    f32x2 e; e.x = __builtin_amdgcn_exp2f(s.x); e.y = __builtin_amdgcn_exp2f(s.y);
    const f32x2 m = v * (q * e), r = v - m;
    f32x2 o; o.x = v.x < 0.f ? m.x : r.x; o.y = v.y < 0.f ? m.y : r.y; return o;
}

template <int ACT  > struct EpiBf16 {
    static constexpr bool PERM = true, AFTER_DRAIN = false; static_assert(ACT == 0 || ACT == 1, "EpiBf16: ACT is 0 (none) or 1 (gelu_pk)");
    bf16_t* O; int ldc; const float* bias; int split_cols; size_t split_stride; float scale0;
    __device__ __forceinline__ void operator()(const f32x4 (&acc)[2][2][4][2], const Unit& u, int wr, int wc, int fr, int fq) const {
        const int row0 = u.pm * BM + wr * 64 + fr; int colt = u.pn * BM; bf16_t* base = O;
        float sc = 1.f; if (split_cols) { const int t = colt / split_cols; base += (size_t)t * split_stride; colt -= t * split_cols; if (t == 0) sc = scale0; }
        const int col0 = colt + wc * 32 + 8 * fq, bcol0 = u.pn * BM + wc * 32 + 8 * fq;
        f32x4 bv[2][2];
#pragma unroll
        for (int bj = 0; bj < 2; ++bj)
#pragma unroll
            for (int n = 0; n < 2; ++n) bv[bj][n] = bias ? *(const f32x4*)(bias + bcol0 + bj * HALF + 4 * n) : (f32x4){0.f, 0.f, 0.f, 0.f};
#pragma unroll
        for (int ai = 0; ai < 2; ++ai)
#pragma unroll
            for (int m = 0; m < 4; ++m) { bf16_t* rowp = base + (size_t)(row0 + ai * HALF + m * 16) * ldc + col0;
#pragma unroll
                for (int bj = 0; bj < 2; ++bj) { f32x4 v0 = acc[ai][bj][m][0] + bv[bj][0], v1 = acc[ai][bj][m][1] + bv[bj][1];
                    if (ACT == 1) { f32x2 a = gelu_pk((f32x2){v0[0], v0[1]}), b = gelu_pk((f32x2){v0[2], v0[3]}), c = gelu_pk((f32x2){v1[0], v1[1]}), d = gelu_pk((f32x2){v1[2], v1[3]});
                        v0 = (f32x4){a.x, a.y, b.x, b.y}; v1 = (f32x4){c.x, c.y, d.x, d.y}; }
                    v0 = v0 * sc; v1 = v1 * sc; u32x4 w; w.x = cvt_pk_bf16(v0[0], v0[1]); w.y = cvt_pk_bf16(v0[2], v0[3]); w.z = cvt_pk_bf16(v1[0], v1[1]); w.w = cvt_pk_bf16(v1[2], v1[3]);
                    *(u32x4*)(rowp + bj * HALF) = w; } }
    }
};
constexpr float K_EPS = 1e-6f, K_LOG2E = 1.4426950408889634f;
constexpr float K_C2 = 0.125f * K_LOG2E;
constexpr float K_C2C = 0.0625f * K_LOG2E;
__device__ __forceinline__ float silu_f(float x) { return x * __builtin_amdgcn_rcpf(1.f + __builtin_amdgcn_exp2f(-x * K_LOG2E)); }
__device__ __forceinline__ float gelu_tanh_f(float x) { const float z2 = x * (1.5957691216057308f + 0.0713548162726009f * x * x); return x * __builtin_amdgcn_rcpf(1.f + __builtin_amdgcn_exp2f(-z2 * K_LOG2E)); }
__device__ __forceinline__ u32x4 pack8(const f32x4 v0, const f32x4 v1) { u32x4 w; w.x = cvt_pk_bf16(v0[0], v0[1]); w.y = cvt_pk_bf16(v0[2], v0[3]); w.z = cvt_pk_bf16(v1[0], v1[1]); w.w = cvt_pk_bf16(v1[2], v1[3]); return w; }
__device__ __forceinline__ float sumsq4(const f32x4 v) { return (v[0] * v[0] + v[1] * v[1]) + (v[2] * v[2] + v[3] * v[3]); }

struct ComboOrder {
    StaticOrder so; int nmain, nextra, xm0, xn0, xnm;
    __host__ __device__ void init(int M, int N, int G_, int c_, int nextra_, int xm0_, int xn0_, int xnm_) { so.init(M, N, G_, c_); nmain = so.nwg; nextra = nextra_; xm0 = xm0_; xn0 = xn0_; xnm = xnm_; }
    __host__ __device__ bool next(int i, Unit& u) const {
        const long L = (long)i * so.G + so.c; if (L < nmain) return so.next(i, u);
        const int j = (int)(L - nmain); if (j >= nextra) return false; u.pm = xm0 + j % xnm; u.pn = xn0 + j / xnm; return true; }
    __device__ __forceinline__ void a_ready(const Unit&) const {}
    __device__ __forceinline__ void done(const Unit&) const {}
};

struct EpiSwiGLU {
    static constexpr bool PERM = true, AFTER_DRAIN = false; static constexpr int MIDK = 0;
    bf16_t* ACT; const float* ss; bf16_t* KV; int nmain_n, nmain_m;
    __device__ __forceinline__ void midk(f32x4 (&)[2][2][4][2], const Unit&, int, int) const {}
    __device__ __forceinline__ void operator()(const f32x4 (&acc)[2][2][4][2], const Unit& u, int wr, int wc, int fr, int fq) const {
        const int rowl = wr * 64 + fr;
        if (u.pn >= nmain_n) {
            const int col0 = (u.pn - nmain_n) * BM + wc * 32 + 8 * fq;
#pragma unroll
            for (int ai = 0; ai < 2; ++ai)
#pragma unroll
                for (int m = 0; m < 4; ++m) { bf16_t* rowp = KV + (size_t)((u.pm - nmain_m) * BM + rowl + ai * HALF + m * 16) * 2048 + col0;
#pragma unroll
                    for (int bj = 0; bj < 2; ++bj) *(u32x4*)(rowp + bj * HALF) = pack8(acc[ai][bj][m][0], acc[ai][bj][m][1]); }
            return;
        }
        const int col0 = u.pn * HALF + wc * 32 + 8 * fq;
#pragma unroll
        for (int ai = 0; ai < 2; ++ai)
#pragma unroll
            for (int m = 0; m < 4; ++m) { const int row = u.pm * BM + rowl + ai * HALF + m * 16; const float rs = ss ? rsqrtf(ss[row] * (1.f / 1024.f) + K_EPS) : 1.f;
                f32x4 h[2];
#pragma unroll
                for (int n = 0; n < 2; ++n) { const f32x4 g = acc[ai][0][m][n] * rs, uu = acc[ai][1][m][n] * rs;
#pragma unroll
                    for (int e = 0; e < 4; ++e) h[n][e] = silu_f(g[e]) * uu[e]; }
                *(u32x4*)(ACT + (size_t)row * 2816 + col0) = pack8(h[0], h[1]); }
    }
};

template <int MIDK_> struct EpiRes {
    static constexpr bool PERM = false, AFTER_DRAIN = false; static constexpr int MIDK = MIDK_;
    const float* xres; float* out; float scale; const float* ss_row; const float* ss_mid; const float* g_next; bf16_t* XN; float* ss_out;
    __device__ __forceinline__ void midk(f32x4 (&acc)[2][2][4][2], const Unit& u, int wr, int fr) const {
        int rb = u.pm * BM + wr * 64 + fr; asm volatile("" : "+v"(rb));
#pragma unroll
        for (int ai = 0; ai < 2; ++ai)
#pragma unroll
            for (int m = 0; m < 4; ++m) { const int row = rb + ai * HALF + m * 16;
                const float f = sqrtf((ss_row[row] * (1.f / 512.f) + K_EPS) / (ss_mid[row] * (1.f / 512.f) + K_EPS));
#pragma unroll
                for (int bj = 0; bj < 2; ++bj)
#pragma unroll
                    for (int n = 0; n < 2; ++n) acc[ai][bj][m][n] *= f;
                asm volatile("" ::: "memory"); }
    }
    __device__ __forceinline__ void operator()(const f32x4 (&acc)[2][2][4][2], const Unit& u, int wr, int wc, int fr, int fq) const {
        typedef unsigned u32x2v __attribute__((ext_vector_type(2)));
        const int col0 = u.pn * BM + wc * 32 + 4 * fq;
#pragma unroll
        for (int ai = 0; ai < 2; ++ai)
#pragma unroll
            for (int m = 0; m < 4; ++m) { const int row = u.pm * BM + wr * 64 + fr + ai * HALF + m * 16; const size_t off = (size_t)row * 1024 + col0;
                const float rsc = scale * (ss_row ? rsqrtf(ss_row[row] * (1.f / 512.f) + K_EPS) : 1.f); float sq = 0.f;
#pragma unroll
                for (int bj = 0; bj < 2; ++bj)
#pragma unroll
                    for (int n = 0; n < 2; ++n) { const int co = bj * HALF + n * 16; const f32x4 o = *(const f32x4*)(xres + off + co) + acc[ai][bj][m][n] * rsc; *(f32x4*)(out + off + co) = o;
                        if (g_next) { const f32x4 gn = *(const f32x4*)(g_next + col0 + co), p = o * gn; u32x2v w; w.x = cvt_pk_bf16(p[0], p[1]); w.y = cvt_pk_bf16(p[2], p[3]); *(u32x2v*)(XN + off + co) = w; sq += sumsq4(o); } }
                if (g_next) { sq += __shfl_xor(sq, 16); sq += __shfl_xor(sq, 32); if (fq == 0) atomicAdd(ss_out + row, sq); } }
    }
};

struct EpiMix {
    static constexpr bool PERM = true, AFTER_DRAIN = false; static constexpr int MIDK = 0;
    const float* ss2; const float* g_q; const float* g_k; bf16_t* QB; float* ssv;
    __device__ __forceinline__ void midk(f32x4 (&)[2][2][4][2], const Unit&, int, int) const {}
    __device__ __forceinline__ void operator()(const f32x4 (&acc)[2][2][4][2], const Unit& u, int wr, int wc, int fr, int fq) const {
        const int pn = u.pn, rowl = wr * 64 + fr;
        if (pn < 4) {
            const float* g = pn < 2 ? g_q : g_k; bf16_t* dst = QB + (size_t)(pn >> 1) * (8u << 20); const float sc = pn < 2 ? K_C2 : 1.f; const int cb = (pn & 1) * 256 + 64 * wc + 8 * fq;
            f32x4 gv[2][2];
#pragma unroll
            for (int bj = 0; bj < 2; ++bj)
#pragma unroll
                for (int n = 0; n < 2; ++n) gv[bj][n] = *(const f32x4*)(g + 32 * bj + 8 * fq + 4 * n) * sc;
#pragma unroll
            for (int ai = 0; ai < 2; ++ai)
#pragma unroll
                for (int m = 0; m < 4; ++m) { const int row = u.pm * BM + rowl + ai * HALF + m * 16; const float rs2 = rsqrtf(ss2[row] * (1.f / 1024.f) + K_EPS);
                    f32x4 v[2][2]; float s = 0.f;
#pragma unroll
                    for (int bj = 0; bj < 2; ++bj)
#pragma unroll
                        for (int n = 0; n < 2; ++n) { v[bj][n] = acc[ai][bj][m][n] * rs2; s += sumsq4(v[bj][n]); }
                    s += __shfl_xor(s, 16); s += __shfl_xor(s, 32);
                    const float rh = rsqrtf(s * (1.f / 64.f) + K_EPS);
#pragma unroll
                    for (int bj = 0; bj < 2; ++bj) *(u32x4*)(dst + (size_t)row * 512 + cb + 32 * bj) = pack8(v[bj][0] * rh * gv[bj][0], v[bj][1] * rh * gv[bj][1]); }
        } else {
            const int grp = (pn - 4) >> 1; bf16_t* dst = QB + (size_t)(pn >> 1) * (8u << 20); const int cb = ((pn - 4) & 1) * 256 + wc * 32 + 8 * fq;
#pragma unroll
            for (int ai = 0; ai < 2; ++ai)
#pragma unroll
                for (int m = 0; m < 4; ++m) { const int row = u.pm * BM + rowl + ai * HALF + m * 16; const float rs2 = rsqrtf(ss2[row] * (1.f / 1024.f) + K_EPS); float sq = 0.f;
#pragma unroll
                    for (int bj = 0; bj < 2; ++bj) { f32x4 v0 = acc[ai][bj][m][0] * rs2, v1 = acc[ai][bj][m][1] * rs2;
                        if (grp) {
#pragma unroll
                            for (int e = 0; e < 4; ++e) { v0[e] = gelu_tanh_f(v0[e]); v1[e] = gelu_tanh_f(v1[e]); } }
                        if (grp == 2) sq += sumsq4(v0) + sumsq4(v1);
                        *(u32x4*)(dst + (size_t)row * 512 + cb + bj * HALF) = pack8(v0, v1); }
                    if (grp == 2) { sq += __shfl_xor(sq, 16); sq += __shfl_xor(sq, 32); if (fq == 0) atomicAdd(ssv + row, sq); } }
        }
    }
};

struct EpiCQ {
    static constexpr bool PERM = true, AFTER_DRAIN = true; static constexpr int MIDK = 0;
    const float* ss3; const float* g_cq; bf16_t* QC;
    __device__ __forceinline__ void midk(f32x4 (&)[2][2][4][2], const Unit&, int, int) const {}
    __device__ __forceinline__ void fused(f32x4 (&acc)[2][2][4][2], const Unit& u, int wr, int wc, int fr, int fq, PG8_LAS unsigned char* lds, int wid, int lane) const {
        PG8_LAS float* P = (PG8_LAS float*)lds;
#pragma unroll
        for (int ai = 0; ai < 2; ++ai)
#pragma unroll
            for (int m = 0; m < 4; ++m) { const int rowl = ai * HALF + wr * 64 + m * 16 + fr; const float r3 = rsqrtf(ss3[u.pm * BM + rowl] * (1.f / 1024.f) + K_EPS); float s = 0.f;
#pragma unroll
                for (int bj = 0; bj < 2; ++bj)
#pragma unroll
                    for (int n = 0; n < 2; ++n) { acc[ai][bj][m][n] *= r3; s += sumsq4(acc[ai][bj][m][n]); }
                s += __shfl_xor(s, 16); s += __shfl_xor(s, 32);
                if (fq == 0) P[rowl * 4 + wc] = s; }
        asm volatile("s_waitcnt lgkmcnt(0)" ::: "memory"); __builtin_amdgcn_s_barrier(); asm volatile("" ::: "memory");
        f32x4 gv[2][2];
#pragma unroll
        for (int bj = 0; bj < 2; ++bj)
#pragma unroll
            for (int n = 0; n < 2; ++n) gv[bj][n] = *(const f32x4*)(g_cq + bj * HALF + wc * 32 + 8 * fq + 4 * n) * K_C2C;
#pragma unroll
        for (int ai = 0; ai < 2; ++ai)
#pragma unroll
            for (int m = 0; m < 4; ++m) { const int rowl = ai * HALF + wr * 64 + m * 16 + fr; const f32x4 t = *(const PG8_LAS f32x4*)(P + rowl * 4);
                const float rh = rsqrtf(((t[0] + t[1]) + (t[2] + t[3])) * (1.f / 256.f) + K_EPS); bf16_t* rowp = QC + (size_t)(u.pm * BM + rowl) * 1024 + u.pn * BM + wc * 32 + 8 * fq;
#pragma unroll
                for (int bj = 0; bj < 2; ++bj) *(u32x4*)(rowp + bj * HALF) = pack8(acc[ai][bj][m][0] * rh * gv[bj][0], acc[ai][bj][m][1] * rh * gv[bj][1]); }
    }
};
template <class Epi, class Sched, bool ALIGN_EPI = false, bool SP2 = false>
__device__ __forceinline__ void gemm_phase(PG8_LAS unsigned char* lds, const Gemm g, const Sched& S, const Epi& E) {
    const int tid = threadIdx.x, wid = __builtin_amdgcn_readfirstlane(tid >> 6), lane = tid & 63, wr = wid >> 2, wc = wid & 3, fr = lane & 15, fq = lane >> 4;
    const int K = g.K, nt = K / BK;
    unsigned voffA[2], voffB[2];
#pragma unroll
    for (int i = 0; i < 2; ++i) { int R, C; stage_rc(tid * 16 + i * 8192, R, C); const int Rb = Epi::PERM ? ((R & ~31) + perm32(R & 31)) : R;
        voffA[i] = (unsigned)(R * K + C) * 2u; voffB[i] = (unsigned)(Rb * K + C) * 2u; }
    const size_t kstep = (size_t)(BK * 2);
    const size_t hstep = (size_t)HALF * K * 2;
    const size_t tstep = 2 * hstep;
    const unsigned ldsw = (unsigned)wid * 1024u;
    const int aoff = lds_byte(wr * 64 + fr, fq * 8), boff = lds_byte(wc * 32 + fr, fq * 8);
#define PG8_SA(b, h) (((b) * 2 + (h)) * HTB)
#define PG8_SB(b, h) ((4 + (b) * 2 + (h)) * HTB)
#define PG8_STAGE(bufoff, gbase, voff) do { _Pragma("unroll") for (int _i = 0; _i < 2; ++_i) \
        __builtin_amdgcn_global_load_lds((const unsigned*)((const char*)(gbase) + (voff)[_i]), (PG8_LAS unsigned*)(lds + (bufoff) + ldsw + _i * 8192), 16, 0, 0); } while (0)
#define PG8_LDA(dst, b, h) do { _Pragma("unroll") for (int m = 0; m < 4; ++m) _Pragma("unroll") for (int k = 0; k < 2; ++k) dst[m][k] = *(const PG8_LAS bf16x8*)(lds + PG8_SA(b, h) + aoff + m * 2048 + k * 1024); } while (0)
#define PG8_LDB(dst, b, h) do { _Pragma("unroll") for (int n = 0; n < 2; ++n) _Pragma("unroll") for (int k = 0; k < 2; ++k) dst[n][k] = *(const PG8_LAS bf16x8*)(lds + PG8_SB(b, h) + boff + n * 2048 + k * 1024); } while (0)
#define PG8_MMA(ai, bj, At, Bt) do { __builtin_amdgcn_s_setprio(1); _Pragma("unroll") for (int m = 0; m < 4; ++m) _Pragma("unroll") for (int n = 0; n < 2; ++n) _Pragma("unroll") for (int k = 0; k < 2; ++k) \
        acc[ai][bj][m][n] = __builtin_amdgcn_mfma_f32_16x16x32_bf16(Bt[n][k], At[m][k], acc[ai][bj][m][n], 0, 0, 0); __builtin_amdgcn_s_setprio(0); } while (0)
#define PG8_WAIT_V(n) asm volatile("s_waitcnt vmcnt(" #n ")" ::: "memory")
#define PG8_WAIT_L(n) asm volatile("s_waitcnt lgkmcnt(" #n ")" ::: "memory")
#define PG8_BAR __builtin_amdgcn_s_barrier()
#define PG8_SCHED __builtin_amdgcn_sched_barrier(0)
    Unit cur, nxt; int ui = 0;
    if (!S.next(0, cur)) return;
    f32x4 acc[2][2][4][2];
#pragma unroll
    for (int a = 0; a < 2; ++a)
#pragma unroll
        for (int b = 0; b < 2; ++b)
#pragma unroll
            for (int m = 0; m < 4; ++m)
#pragma unroll
                for (int n = 0; n < 2; ++n) acc[a][b][m][n] = (f32x4){0.f, 0.f, 0.f, 0.f};
    bf16x8 At[4][2], B0[2][2], B1[2][2];
    const char* cA = (const char*)g.A + (size_t)cur.pm * tstep; const char* cB = (const char*)g.Bt + (size_t)cur.pn * tstep;
    S.a_ready(cur);
    if constexpr (SP2) {
        PG8_STAGE(PG8_SB(0, 0), cB, voffB); PG8_STAGE(PG8_SB(0, 1), cB + hstep, voffB); PG8_STAGE(PG8_SA(0, 0), cA, voffA); PG8_STAGE(PG8_SA(0, 1), cA + hstep, voffA);
        if (wr == 1) PG8_BAR;
        PG8_WAIT_V(2); PG8_BAR;
        PG8_STAGE(PG8_SB(1, 0), cB + kstep, voffB); PG8_STAGE(PG8_SA(1, 0), cA + kstep, voffA); PG8_STAGE(PG8_SB(1, 1), cB + hstep + kstep, voffB);
        PG8_WAIT_V(6); PG8_BAR;
    } else {
        PG8_STAGE(PG8_SB(0, 0), cB, voffB); PG8_STAGE(PG8_SA(0, 0), cA, voffA); PG8_STAGE(PG8_SB(0, 1), cB + hstep, voffB); PG8_STAGE(PG8_SA(0, 1), cA + hstep, voffA);
        if (wr == 1) PG8_BAR;
        PG8_WAIT_V(4); PG8_BAR;
        PG8_STAGE(PG8_SB(1, 0), cB + kstep, voffB); PG8_STAGE(PG8_SA(1, 0), cA + kstep, voffA); PG8_STAGE(PG8_SB(1, 1), cB + hstep + kstep, voffB);
        PG8_WAIT_V(6); PG8_BAR;
    }
    for (;;) {
        const bool has_next = S.next(ui + 1, nxt);
        const char* nA = has_next ? (const char*)g.A + (size_t)nxt.pm * tstep : cA; const char* nB = has_next ? (const char*)g.Bt + (size_t)nxt.pn * tstep : cB;
        for (int t = 0; t < nt; t += 2) {
            if constexpr (Epi::MIDK > 0) { if (t == Epi::MIDK) E.midk(acc, cur, wr, fr); }
            const bool last = (t == nt - 2);
            const char* a1 = cA + (size_t)(t + 1) * kstep;
            const char* a2 = last ? nA : cA + (size_t)(t + 2) * kstep; const char* b2 = last ? nB : cB + (size_t)(t + 2) * kstep;
            const char* a3 = a2 + kstep; const char* b3 = b2 + kstep;
            if (last && has_next) S.a_ready(nxt);
            if constexpr (SP2) {
            PG8_LDB(B0, 0, 0); PG8_LDB(B1, 0, 1); PG8_SCHED; PG8_LDA(At, 0, 0); PG8_STAGE(PG8_SA(1, 1), a1 + hstep, voffA);
            PG8_WAIT_V(8); PG8_WAIT_L(0); PG8_BAR; PG8_MMA(0, 0, At, B0); PG8_MMA(0, 1, At, B1); PG8_BAR; PG8_SCHED;
            PG8_LDA(At, 0, 1); PG8_STAGE(PG8_SB(0, 0), b2, voffB); PG8_STAGE(PG8_SB(0, 1), b2 + hstep, voffB); PG8_STAGE(PG8_SA(0, 0), a2, voffA);
            PG8_WAIT_V(8); PG8_WAIT_L(0); PG8_BAR; PG8_MMA(1, 0, At, B0); PG8_MMA(1, 1, At, B1); PG8_BAR; PG8_SCHED;
            PG8_LDB(B0, 1, 0); PG8_LDB(B1, 1, 1); PG8_SCHED; PG8_LDA(At, 1, 0); PG8_STAGE(PG8_SA(0, 1), a2 + hstep, voffA);
            PG8_WAIT_V(8); PG8_WAIT_L(0); PG8_BAR; PG8_MMA(0, 0, At, B0); PG8_MMA(0, 1, At, B1); PG8_BAR; PG8_SCHED;
            PG8_LDA(At, 1, 1); PG8_STAGE(PG8_SB(1, 0), b3, voffB); PG8_STAGE(PG8_SB(1, 1), b3 + hstep, voffB); PG8_STAGE(PG8_SA(1, 0), a3, voffA);
            PG8_WAIT_V(8); PG8_WAIT_L(0); PG8_BAR; PG8_MMA(1, 0, At, B0); PG8_MMA(1, 1, At, B1); PG8_BAR; PG8_SCHED;
            } else {
            PG8_LDB(B0, 0, 0); PG8_SCHED; PG8_LDA(At, 0, 0); PG8_STAGE(PG8_SA(1, 1), a1 + hstep, voffA);
            PG8_WAIT_L(8); PG8_BAR; PG8_WAIT_L(0); PG8_MMA(0, 0, At, B0); PG8_BAR; PG8_SCHED;
            PG8_LDB(B1, 0, 1); PG8_STAGE(PG8_SB(0, 0), b2, voffB);
            PG8_BAR; PG8_WAIT_L(0); PG8_MMA(0, 1, At, B1); PG8_BAR;
            PG8_LDA(At, 0, 1); PG8_STAGE(PG8_SA(0, 0), a2, voffA);
            PG8_BAR; PG8_WAIT_L(0); PG8_MMA(1, 0, At, B0); PG8_BAR; PG8_SCHED;
            PG8_STAGE(PG8_SB(0, 1), b2 + hstep, voffB);
            PG8_WAIT_V(6); PG8_BAR; PG8_MMA(1, 1, At, B1); PG8_BAR;
            PG8_LDB(B0, 1, 0); PG8_SCHED; PG8_LDA(At, 1, 0); PG8_STAGE(PG8_SA(0, 1), a2 + hstep, voffA);
            PG8_WAIT_L(8); PG8_BAR; PG8_WAIT_L(0); PG8_MMA(0, 0, At, B0); PG8_BAR; PG8_SCHED;
            PG8_LDB(B1, 1, 1); PG8_STAGE(PG8_SB(1, 0), b3, voffB);
            PG8_BAR; PG8_WAIT_L(0); PG8_MMA(0, 1, At, B1); PG8_BAR;
            PG8_LDA(At, 1, 1); PG8_STAGE(PG8_SA(1, 0), a3, voffA);
            PG8_BAR; PG8_WAIT_L(0); PG8_MMA(1, 0, At, B0); PG8_BAR; PG8_SCHED;
            PG8_STAGE(PG8_SB(1, 1), b3 + hstep, voffB);
            PG8_WAIT_V(6); PG8_BAR; PG8_MMA(1, 1, At, B1); PG8_BAR;
            }
        }
        if constexpr (ALIGN_EPI) { if (wr == 0) PG8_BAR; }
        if constexpr (!Epi::AFTER_DRAIN) { E(acc, cur, wr, wc, fr, fq); S.done(cur); }
        if (!has_next) break;
#pragma unroll
        for (int a = 0; a < 2; ++a)
#pragma unroll
            for (int b = 0; b < 2; ++b)
#pragma unroll
                for (int m = 0; m < 4; ++m)
#pragma unroll
                    for (int n = 0; n < 2; ++n) acc[a][b][m][n] = (f32x4){0.f, 0.f, 0.f, 0.f};
        cur = nxt; cA = nA; cB = nB; ++ui;
        if constexpr (ALIGN_EPI) { if (wr == 1) PG8_BAR; }
    }
    PG8_WAIT_V(0);
    if constexpr (!ALIGN_EPI) { if (wr == 0) PG8_BAR; }
    PG8_BAR;
    if constexpr (Epi::AFTER_DRAIN) { E.fused(acc, cur, wr, wc, fr, fq, lds, wid, lane); S.done(cur); }
#undef PG8_SA
#undef PG8_SB
#undef PG8_STAGE
#undef PG8_LDA
#undef PG8_LDB
#undef PG8_MMA
#undef PG8_WAIT_V
#undef PG8_WAIT_L
#undef PG8_BAR
#undef PG8_SCHED
}
}
#ifndef PG8_SP2
#define PG8_SP2 true
#endif
#ifndef PG8_ALIGN
#define PG8_ALIGN true
#endif
namespace attn_body {
using bf16=__hip_bfloat16;
using bf16x8=__attribute__((ext_vector_type(8)))short;
using s16x4=__attribute__((ext_vector_type(4)))short;
using f32x16=__attribute__((ext_vector_type(16)))float;
using u32x4=__attribute__((ext_vector_type(4)))unsigned;
constexpr int BATCH=4,NHEAD=8,SEQ=4096,D=64,DM=NHEAD*D;
constexpr int NW=8,QBLK=32,QB=QBLK*NW,KVBLK=64,NQB=SEQ/QB;
constexpr int ATTN_PITCH=DM, ATTN_UNIT_ROWS=QB;
__device__ __forceinline__ int crow(int r,int hi){return (r&3)+8*(r>>2)+4*hi;}
#define SBAR() __builtin_amdgcn_sched_barrier(0)
__device__ __forceinline__ void cmask(f32x16&p0,f32x16&p1,int jb,int qrel,int hi){
  const float NEG=-INFINITY; int kb=64*jb+4*hi;
  #pragma unroll
  for(int r=0;r<16;++r){int kv=kb+(r&3)+8*(r>>2); if(kv>qrel)p0[r]=NEG; if(kv+32>qrel)p1[r]=NEG;}
}

constexpr int NSLOT=3, SLOTB=8192;
constexpr int LDS_K=0, LDS_V=NSLOT*SLOTB, LDS_WS=2*NSLOT*SLOTB, LDS_OST=LDS_WS+NW*64*4, LDS_C=LDS_OST+NW*4096, LDS_SCAN=LDS_C+SEQ*4, LDS_BYTES=LDS_SCAN+64;
constexpr float C2=0.125f*1.4426950408889634f;
__device__ __forceinline__ void glds16(const void*gsrc,unsigned lds_dst){unsigned keep;
  asm volatile("s_mov_b32 %0, m0\n\ts_mov_b32 m0, %2\n\ts_nop 0\n\tglobal_load_lds_dwordx4 %1, off\n\ts_mov_b32 m0, %0":"=&s"(keep):"v"(gsrc),"s"(lds_dst):"memory");}
__device__ __forceinline__ float max3f(float a,float b,float c){float r;asm("v_max3_f32 %0, %1, %2, %3":"=v"(r):"v"(a),"v"(b),"v"(c));return r;}
__device__ __forceinline__ float max2f(float a,float b){float r;asm("v_max_f32_e32 %0, %1, %2":"=v"(r):"v"(a),"v"(b));return r;}
__device__ __forceinline__ float fadd_s(float a,float b){float r;asm("v_add_f32_e32 %0, %1, %2":"=v"(r):"v"(a),"v"(b));return r;}
__device__ __forceinline__ float fsub_s(float a,float b){float r;asm("v_sub_f32_e32 %0, %1, %2":"=v"(r):"v"(a),"v"(b));return r;}
typedef float f32x2_t __attribute__((ext_vector_type(2))); typedef __bf16 bf16x2_t __attribute__((ext_vector_type(2)));
__device__ __forceinline__ unsigned cvtpk_s(float lo,float hi){f32x2_t v={lo,hi};bf16x2_t b=__builtin_convertvector(v,bf16x2_t);return __builtin_bit_cast(unsigned,b);}
#define WAIT_BAR(N) asm volatile("s_waitcnt vmcnt(" #N ") lgkmcnt(0)\n\ts_barrier":::"memory")

__device__ __forceinline__ void qkt(f32x16&p0,f32x16&p1,const char*Kslot,const bf16x8*qr,int r32,int hi){
  const char*kb=Kslot+hi*1024+r32*16;
  #pragma unroll
  for(int d0=0;d0<4;++d0){
    const bf16x8 b0=*reinterpret_cast<const bf16x8*>(kb+d0*2048);
    const bf16x8 b1=*reinterpret_cast<const bf16x8*>(kb+d0*2048+512);
    p0=__builtin_amdgcn_mfma_f32_32x32x16_bf16(b0,qr[d0],p0,0,0,0);p1=__builtin_amdgcn_mfma_f32_32x32x16_bf16(b1,qr[d0],p1,0,0,0);}
}
typedef __attribute__((address_space(3))) const char* lds_cptr;
typedef short v4i16_t __attribute__((ext_vector_type(4)));
__device__ __forceinline__ void kload8(bf16x8*kf,lds_cptr kp){
  kf[0]=*(const __attribute__((address_space(3))) bf16x8*)(kp);      kf[1]=*(const __attribute__((address_space(3))) bf16x8*)(kp+512);
  kf[2]=*(const __attribute__((address_space(3))) bf16x8*)(kp+2048); kf[3]=*(const __attribute__((address_space(3))) bf16x8*)(kp+2560);
  kf[4]=*(const __attribute__((address_space(3))) bf16x8*)(kp+4096); kf[5]=*(const __attribute__((address_space(3))) bf16x8*)(kp+4608);
  kf[6]=*(const __attribute__((address_space(3))) bf16x8*)(kp+6144); kf[7]=*(const __attribute__((address_space(3))) bf16x8*)(kp+6656);
}
__device__ __forceinline__ void kload2(bf16x8*kf,lds_cptr kp,int j){ kf[2*j]=*(const __attribute__((address_space(3))) bf16x8*)(kp+j*2048); kf[2*j+1]=*(const __attribute__((address_space(3))) bf16x8*)(kp+j*2048+512); }
__device__ __forceinline__ s16x4 vtr(lds_cptr p){ return __builtin_bit_cast(s16x4,__builtin_amdgcn_ds_read_tr16_b64_v4i16((__attribute__((address_space(3))) v4i16_t*)p)); }
__device__ __forceinline__ float rowmax(const f32x16&p0,const f32x16&p1){
  float a=max3f(p0[0],p0[1],p1[0]),b=max3f(p0[2],p0[3],p1[1]);a=max3f(a,p1[2],p1[3]);
  #pragma unroll
  for(int r=4;r<16;r+=4){a=max3f(a,p0[r],p0[r+1]);b=max3f(b,p0[r+2],p0[r+3]);a=max3f(a,p1[r],p1[r+1]);b=max3f(b,p1[r+2],p1[r+3]);}
  const float m=max2f(a,b);
  auto rr=__builtin_amdgcn_permlane32_swap(__float_as_uint(m),__float_as_uint(m),false,false);
  return max2f(__uint_as_float(rr[0]),__uint_as_float(rr[1]));
}
__device__ __forceinline__ void pv(f32x16*o,int vb,bf16x8 pa0,bf16x8 pa1,bf16x8 pa2,bf16x8 pa3){
  #pragma unroll
  for(int d0=0;d0<2;++d0){s16x4 lo[4],hi[4];
    #pragma unroll
    for(int ks=0;ks<4;++ks){
      asm volatile("ds_read_b64_tr_b16 %0,%1 offset:%c2":"=&v"(lo[ks]):"v"(vb),"i"(d0*4096+ks*1024):"memory");
      asm volatile("ds_read_b64_tr_b16 %0,%1 offset:%c2":"=&v"(hi[ks]):"v"(vb),"i"(d0*4096+ks*1024+512):"memory");}
    asm volatile("s_waitcnt lgkmcnt(0)":::"memory");SBAR();
    #define PK(k) (bf16x8){lo[k][0],lo[k][1],lo[k][2],lo[k][3],hi[k][0],hi[k][1],hi[k][2],hi[k][3]}
    o[d0]=__builtin_amdgcn_mfma_f32_32x32x16_bf16(pa0,PK(0),o[d0],0,0,0);
    o[d0]=__builtin_amdgcn_mfma_f32_32x32x16_bf16(pa1,PK(1),o[d0],0,0,0);
    o[d0]=__builtin_amdgcn_mfma_f32_32x32x16_bf16(pa2,PK(2),o[d0],0,0,0);
    o[d0]=__builtin_amdgcn_mfma_f32_32x32x16_bf16(pa3,PK(3),o[d0],0,0,0);
    #undef PK
  }
}

#ifndef ATTN_STORE16
#define ATTN_STORE16(p,v) (*(u32x4*)(p)=(v))
#endif
template<int THRL> __device__ __forceinline__ void attn_unit(int b,int h,int qb,const bf16*Q,const bf16*__restrict__ K,const bf16*__restrict__ V,unsigned short*Y,const float*gfo,float*ssa,char*shm){
  const int tid=threadIdx.x,lane=tid&63,r32=lane&31,hi=lane>>5; const int wid=__builtin_amdgcn_readfirstlane(tid>>6);
  const long rowbase=(long)b*SEQ; const int q0=qb*QB;
  const bf16*Qw=Q+(rowbase+q0+wid*QBLK)*DM+h*D;
  const bf16*Kh=K+rowbase*DM+h*D,*Vh=V+rowbase*DM+h*D;
  const unsigned lds0=(unsigned)(uintptr_t)shm;
  float*wsf=(float*)(shm+LDS_WS)+wid*64;
  const bf16*ksrc=Kh+(long)lane*DM+wid*8;
  const bf16*vsrc=Vh+(long)(16*(wid&3)+(lane>>2))*DM+(wid>>2)*32+(lane&3)*8;
  const unsigned kdst=lds0+LDS_K+wid*1024, vdst=lds0+LDS_V+wid*1024;
  #define DMA_K(t,slot) glds16(ksrc+(long)(t)*KVBLK*DM,(unsigned)__builtin_amdgcn_readfirstlane(kdst+(slot)))
  #define DMA_V(t,slot) glds16(vsrc+(long)(t)*KVBLK*DM,(unsigned)__builtin_amdgcn_readfirstlane(vdst+(slot)))
  const int vb0=(int)(lds0+LDS_V)+((lane>>4)&1)*32+(lane&3)*8+(4*hi+((lane&15)>>2))*64;
  const char*Kbase=shm+LDS_K; bf16x8 kf[8];
  const lds_cptr shm3=(lds_cptr)shm; const lds_cptr kp0=shm3+LDS_K+hi*1024+r32*16; const lds_cptr vp0=shm3+LDS_V+((lane>>4)&1)*32+(lane&3)*8+(4*hi+((lane&15)>>2))*64;
  const int NT=(q0+QB)/KVBLK;
  DMA_K(0,0);DMA_V(0,0);DMA_K(1,SLOTB);
  bf16x8 qr[4];
  #pragma unroll
  for(int d0=0;d0<4;++d0)qr[d0]=*reinterpret_cast<const bf16x8*>(&Qw[(long)r32*DM+d0*16+hi*8]);
  float mhat=0.f,l_reg=0.f;f32x16 o[2];o[0]=f32x16{};o[1]=f32x16{};
  typedef float f32x4_t __attribute__((ext_vector_type(4)));
  const __attribute__((address_space(3))) f32x4_t* cl4=(const __attribute__((address_space(3))) f32x4_t*)((lds_cptr)shm+LDS_C)+hi;
  mhat=-((const __attribute__((address_space(3))) float*)((lds_cptr)shm+LDS_C))[q0+wid*QBLK+r32];
  #define BIAS(C0,C1,t) do{ const float bs_=-mhat; _Pragma("unroll") for(int j_=0;j_<4;++j_){ const f32x4_t a_=cl4[16*(t)+2*j_], b_=cl4[16*(t)+8+2*j_]; \
      _Pragma("unroll") for(int e_=0;e_<4;++e_){ C0[4*j_+e_]=bs_-a_[e_]; C1[4*j_+e_]=bs_-b_[e_]; } } }while(0)
  const int qrel=wid*QBLK+r32;
  #define CMASK(P0,P1,t) do{int jb_=(t)-(NT-4); if(jb_>=0)cmask(P0,P1,jb_,qrel,hi);}while(0)
  bool resc=false;
  #define START(P0,P1) do{ const float rm=rowmax(P0,P1); resc=false; \
    { const float dl=rm; mhat=fadd_s(mhat,dl); \
      _Pragma("unroll") for(int r=0;r<16;++r){P0[r]=fsub_s(P0[r],dl);P1[r]=fsub_s(P1[r],dl);} \
      } \
    _Pragma("unroll") for(int r=0;r<16;++r)P0[r]=__builtin_amdgcn_exp2f(P0[r]); }while(0)
  #define RESC() do{ if(resc){ asm volatile("s_waitcnt lgkmcnt(0)":::"memory"); \
      _Pragma("unroll") for(int d_=0;d_<2;++d_) _Pragma("unroll") for(int r=0;r<16;++r)o[d_][r]*=wsf[crow(r,hi)]; } }while(0)
  f32x16 pA0,pA1,pB0,pB1;
  int sl_prev=0,sl_cur=0,sl_next=SLOTB;
  #define ROT() do{sl_prev=sl_cur;sl_cur=sl_next;sl_next=(sl_next==(NSLOT-1)*SLOTB)?0:sl_next+SLOTB;}while(0)
  DMA_K(2,2*SLOTB);
  WAIT_BAR(3);
  BIAS(pA0,pA1,0); qkt(pA0,pA1,Kbase,qr,r32,hi);asm volatile("s_nop 15\n\ts_nop 7":"+v"(pA0),"+v"(pA1));CMASK(pA0,pA1,0);
  START(pA0,pA1);
  _Pragma("unroll") for(int r=0;r<16;++r)pA1[r]=__builtin_amdgcn_exp2f(pA1[r]);
  WAIT_BAR(0);
  DMA_K(3,0);DMA_V(1,SLOTB);
  ROT();
  kload8(kf,kp0+sl_cur);
  WAIT_BAR(2);
  s16x4 vlo[8],vhi[8]; u32x4 pw0,pw1,pw2,pw3;
  #define PKW(P,B) cvtpk_s(P[B],P[B+1])
  #define PAF(k) __builtin_bit_cast(bf16x8,pw##k)
  #define VFR(i) (bf16x8){vlo[i][0],vlo[i][1],vlo[i][2],vlo[i][3],vhi[i][0],vhi[i][1],vhi[i][2],vhi[i][3]}
  #define PIN(x) asm volatile("":"+v"(x))
  #define MX3(a,b,c) __builtin_fmaxf(__builtin_fmaxf((a),(b)),(c))
  #define GAPA(MF,A0,A1,A2,A3,W0,W1,PW) do{ MF; sacc+=A0; sacc+=A1; sacc+=A2; sacc+=A3; PIN(sacc); W0; W1; PIN(PW); SBAR(); }while(0)
  #define EX(v) __builtin_amdgcn_exp2f(v)
  #define GAPB(MF,X,B) do{ MF; X[B]=EX(X[B]); X[B+1]=EX(X[B+1]); X[B+2]=EX(X[B+2]); X[B+3]=EX(X[B+3]); PIN(X); SBAR(); }while(0)
  #define VRD(i) do{ vlo[i]=vtr(vp_+(((i)>>2)*4096+((i)&3)*1024)); vhi[i]=vtr(vp_+(((i)>>2)*4096+((i)&3)*1024+512)); }while(0)
  #define KRD(G,j) do{ if(G){ kload2(kf,kp0+sl_next,j); SBAR(); } }while(0)
  #define STEP(C0,C1,P0,P1,t,GK,GV,GL) do{ BIAS(C0,C1,t); SBAR(); \
    const lds_cptr vp_=vp0+sl_prev; \
    VRD(0); SBAR(); float sacc=(P0[0]+P0[1]); \
    GAPA(C0=__builtin_amdgcn_mfma_f32_32x32x16_bf16(kf[0],qr[0],C0,0,0,0), P0[2],P0[3],P0[4],P0[5],     pw0[0]=PKW(P0,0), pw0[1]=PKW(P0,2), pw0); \
    VRD(4); SBAR(); GAPA(C1=__builtin_amdgcn_mfma_f32_32x32x16_bf16(kf[1],qr[0],C1,0,0,0), P0[6],P0[7],P0[8],P0[9],     pw0[2]=PKW(P0,4), pw0[3]=PKW(P0,6), pw0); \
    VRD(1); SBAR(); GAPA(C0=__builtin_amdgcn_mfma_f32_32x32x16_bf16(kf[2],qr[1],C0,0,0,0),   P0[10],P0[11],P0[12],P0[13], pw1[0]=PKW(P0,8), pw1[1]=PKW(P0,10), pw1); \
    VRD(5); SBAR(); GAPA(C1=__builtin_amdgcn_mfma_f32_32x32x16_bf16(kf[3],qr[1],C1,0,0,0),   P0[14],P0[15],P1[0],P1[1],   pw1[2]=PKW(P0,12),pw1[3]=PKW(P0,14), pw1); \
    VRD(2); SBAR(); GAPA(C0=__builtin_amdgcn_mfma_f32_32x32x16_bf16(kf[4],qr[2],C0,0,0,0),   P1[2],P1[3],P1[4],P1[5],     pw2[0]=PKW(P1,0), pw2[1]=PKW(P1,2), pw2); \
    VRD(6); SBAR(); GAPA(C1=__builtin_amdgcn_mfma_f32_32x32x16_bf16(kf[5],qr[2],C1,0,0,0),   P1[6],P1[7],P1[8],P1[9],     pw2[2]=PKW(P1,4), pw2[3]=PKW(P1,6), pw2); \
    VRD(3); SBAR(); GAPA(C0=__builtin_amdgcn_mfma_f32_32x32x16_bf16(kf[6],qr[3],C0,0,0,0),   P1[10],P1[11],P1[12],P1[13], pw3[0]=PKW(P1,8), pw3[1]=PKW(P1,10), pw3); \
    VRD(7); SBAR(); GAPA(C1=__builtin_amdgcn_mfma_f32_32x32x16_bf16(kf[7],qr[3],C1,0,0,0),   P1[14],P1[15],0.f,0.f,       pw3[2]=PKW(P1,12),pw3[3]=PKW(P1,14), pw3); \
    l_reg+=sacc; \
    if(GK){DMA_K((t)+3,sl_cur);} if(GV){DMA_V((t)+1,sl_next);} \
    CMASK(C0,C1,t); \
    { float a=MX3(C0[0],C0[1],C1[0]),b=MX3(C0[2],C0[3],C1[1]); a=MX3(a,C1[2],C1[3]); \
      _Pragma("unroll") for(int r=4;r<16;r+=4){a=MX3(a,C0[r],C0[r+1]);b=MX3(b,C0[r+2],C0[r+3]);a=MX3(a,C1[r],C1[r+1]);b=MX3(b,C1[r+2],C1[r+3]);} \
      float rm=__builtin_fmaxf(a,b); { auto rr=__builtin_amdgcn_permlane32_swap(__float_as_uint(rm),__float_as_uint(rm),false,false); rm=__builtin_fmaxf(__uint_as_float(rr[0]),__uint_as_float(rr[1])); } \
      resc=false; \
      if(__builtin_expect(__any(rm>(float)THRL),0)){ const float dl=__builtin_fmaxf(rm,0.f); mhat+=dl; \
        _Pragma("unroll") for(int r=0;r<16;++r){C0[r]-=dl;C1[r]-=dl;} \
        const float f=__builtin_amdgcn_exp2f(-dl); l_reg*=f; if(hi==0)wsf[r32]=f; resc=true; } } \
    SBAR(); \
    GAPB(o[0]=__builtin_amdgcn_mfma_f32_32x32x16_bf16(PAF(0),VFR(0),o[0],0,0,0), C0,0); \
    GAPB(o[1]=__builtin_amdgcn_mfma_f32_32x32x16_bf16(PAF(0),VFR(4),o[1],0,0,0), C0,4); \
    KRD(GL,0); GAPB(o[0]=__builtin_amdgcn_mfma_f32_32x32x16_bf16(PAF(1),VFR(1),o[0],0,0,0), C0,8); \
    KRD(GL,1); GAPB(o[1]=__builtin_amdgcn_mfma_f32_32x32x16_bf16(PAF(1),VFR(5),o[1],0,0,0), C0,12); \
    KRD(GL,2); GAPB(o[0]=__builtin_amdgcn_mfma_f32_32x32x16_bf16(PAF(2),VFR(2),o[0],0,0,0), C1,0); \
    KRD(GL,3); GAPB(o[1]=__builtin_amdgcn_mfma_f32_32x32x16_bf16(PAF(2),VFR(6),o[1],0,0,0), C1,4); \
    GAPB(o[0]=__builtin_amdgcn_mfma_f32_32x32x16_bf16(PAF(3),VFR(3),o[0],0,0,0), C1,8); \
    GAPB(o[1]=__builtin_amdgcn_mfma_f32_32x32x16_bf16(PAF(3),VFR(7),o[1],0,0,0), C1,12); \
    }while(0)
  int t=1;
  #undef CMASK
  #define CMASK(P0,P1,t) do{}while(0)
  for(;t+5<NT;t+=2){
    STEP(pB0,pB1,pA0,pA1,t,true,true,true);     WAIT_BAR(2); RESC(); ROT();
    STEP(pA0,pA1,pB0,pB1,t+1,true,true,true);   WAIT_BAR(2); RESC(); ROT();
  }
  #undef CMASK
  #define CMASK(P0,P1,t) do{int jb_=(t)-(NT-4); if(jb_>=0)cmask(P0,P1,jb_,qrel,hi);}while(0)
  #define ENDW(tt) do{ if((tt)+3<NT){WAIT_BAR(2);} else if((tt)+2<NT){WAIT_BAR(1);} else {WAIT_BAR(0);} }while(0)
  for(;t+1<NT;t+=2){
    STEP(pB0,pB1,pA0,pA1,t,(t+3<NT),(t+1<NT),(t+1<NT));       ENDW(t);   RESC(); ROT();
    STEP(pA0,pA1,pB0,pB1,t+1,(t+4<NT),(t+2<NT),(t+2<NT));     ENDW(t+1); RESC(); ROT();
  }
  STEP(pB0,pB1,pA0,pA1,NT-1,false,false,false); RESC();
  { float sacc=pB0[0]+pB0[1]; _Pragma("unroll") for(int r=2;r<16;++r)sacc+=pB0[r]; _Pragma("unroll") for(int r=0;r<16;++r)sacc+=pB1[r]; l_reg+=sacc;
    pw0=(u32x4){PKW(pB0,0),PKW(pB0,2),PKW(pB0,4),PKW(pB0,6)};pw1=(u32x4){PKW(pB0,8),PKW(pB0,10),PKW(pB0,12),PKW(pB0,14)};pw2=(u32x4){PKW(pB1,0),PKW(pB1,2),PKW(pB1,4),PKW(pB1,6)};pw3=(u32x4){PKW(pB1,8),PKW(pB1,10),PKW(pB1,12),PKW(pB1,14)};
    SBAR(); pv(o,vb0+sl_cur,PAF(0),PAF(1),PAF(2),PAF(3)); }
  #undef PKW
  #undef PAF
  #undef VFR
  #undef PIN
  #undef MX3
  #undef GAPA
  #undef GAPB
  #undef EX
  #undef VRD
  #undef KRD
  #undef STEP
  #undef ENDW
  {auto rr=__builtin_amdgcn_permlane32_swap(__float_as_uint(l_reg),__float_as_uint(l_reg),false,false);l_reg=__uint_as_float(rr[0])+__uint_as_float(rr[1]);}
  if(hi==0)wsf[32+r32]=l_reg;asm volatile("s_waitcnt lgkmcnt(0)":::"memory");
  float rli[16];
  #pragma unroll
  for(int r=0;r<16;++r)rli[r]=__builtin_amdgcn_rcpf(wsf[32+crow(r,hi)]);
  unsigned short*Ow=Y+(rowbase+q0+wid*QBLK)*1024+h*D; float*ssw=ssa+(rowbase+q0+wid*QBLK);
  { bf16*stg=(bf16*)(shm+LDS_OST)+wid*2048;
    #pragma unroll
    for(int r=0;r<16;++r){const int orow=crow(r,hi);
      #pragma unroll
      for(int d0=0;d0<2;++d0)stg[orow*64+d0*32+r32]=__float2bfloat16(o[d0][r]*rli[r]);}
    asm volatile("s_waitcnt lgkmcnt(0)":::"memory");
    #pragma unroll
    for(int i=0;i<4;++i){const int row=i*8+(lane>>3),ch=lane&7; const u32x4 v=*(const u32x4*)(stg+row*64+ch*8);
      const f32x4_t g0=*(const f32x4_t*)(gfo+h*D+ch*8), g1=*(const f32x4_t*)(gfo+h*D+ch*8+4); float sq=0.f; u32x4 w;
      { const float a0=__uint_as_float(v[0]<<16),a1=__uint_as_float(v[0]&0xffff0000u),a2=__uint_as_float(v[1]<<16),a3=__uint_as_float(v[1]&0xffff0000u); sq+=(a0*a0+a1*a1)+(a2*a2+a3*a3); w[0]=cvtpk_s(a0*g0[0],a1*g0[1]); w[1]=cvtpk_s(a2*g0[2],a3*g0[3]); }
      { const float a0=__uint_as_float(v[2]<<16),a1=__uint_as_float(v[2]&0xffff0000u),a2=__uint_as_float(v[3]<<16),a3=__uint_as_float(v[3]&0xffff0000u); sq+=(a0*a0+a1*a1)+(a2*a2+a3*a3); w[2]=cvtpk_s(a0*g1[0],a1*g1[1]); w[3]=cvtpk_s(a2*g1[2],a3*g1[3]); }
      sq+=__shfl_xor(sq,1); sq+=__shfl_xor(sq,2); sq+=__shfl_xor(sq,4); if(ch==0)atomicAdd(ssw+row,sq);
      *(u32x4*)(Ow+(long)row*1024+ch*8)=w;} }
  asm volatile("s_waitcnt lgkmcnt(0)\n\ts_barrier":::"memory");
  #undef DMA_K
  #undef DMA_V
  #undef CMASK
  #undef START
  #undef RESC
  #undef ROT
  #undef BIAS
}
constexpr int ATTN_LDS_BYTES=LDS_BYTES;
struct AttnTensors { const bf16* Q; const bf16* K; const bf16* V; unsigned short* Y; const float* gfo; float* ssa; const float* logf; };
struct AttnUnit { int bh; int qb; };
struct StaticOrder {
  int vcu;
  __device__ __forceinline__ explicit StaticOrder(int grid,int block):vcu((block%8)*(grid/8)+block/8){}
  __device__ __forceinline__ bool next(int i,AttnUnit&u)const{ if(i>=2)return false; const int s=vcu&7; u.bh=vcu>>3; u.qb=(i==0)?s:15-s; return true; }
  __device__ __forceinline__ void a_ready(const AttnUnit&)const{}
  __device__ __forceinline__ void done(const AttnUnit&)const{}
};
template<class Sched,int THRL=8> __device__ __forceinline__ void attn_phase(char*lds,const AttnTensors&T,const Sched&S){
  AttnUnit u;
  if(!S.next(0,u))return;
  {
    typedef float f32x4_t __attribute__((ext_vector_type(4)));
    const int tid=threadIdx.x,lane=tid&63,wid=tid>>6; const f32x4_t*src=(const f32x4_t*)(T.logf+(long)u.bh*SEQ)+2*tid; const f32x4_t a=src[0],b=src[1];
    f32x4_t v0=a,v1=b; v0[1]+=v0[0]; v0[2]+=v0[1]; v0[3]+=v0[2]; v1[0]+=v0[3]; v1[1]+=v1[0]; v1[2]+=v1[1]; v1[3]+=v1[2];
    float inc=v1[3];
    _Pragma("unroll") for(int o=1;o<64;o<<=1){ const float t=__shfl_up(inc,o); if(lane>=o)inc+=t; }
    float*scan=(float*)(lds+LDS_SCAN); if(lane==63)scan[wid]=inc;
    asm volatile("s_waitcnt lgkmcnt(0)\n\ts_barrier":::"memory");
    float base=inc-v1[3]; for(int w=0;w<wid;++w)base+=scan[w];
    f32x4_t*cl=(f32x4_t*)(lds+LDS_C)+2*tid;
    cl[0]=(v0+base)*1.4426950408889634f; cl[1]=(v1+base)*1.4426950408889634f;
    asm volatile("s_waitcnt lgkmcnt(0)\n\ts_barrier":::"memory");
  }
  for(int i=0;S.next(i,u);++i){ S.a_ready(u); attn_unit<THRL>(u.bh/NHEAD,u.bh%NHEAD,u.qb,T.Q,T.K,T.V,T.Y,T.gfo,T.ssa,lds); S.done(u); }
}
#undef SBAR
#undef WAIT_BAR
}
#define GAS __attribute__((address_space(1)))
#define LAS __attribute__((address_space(3)))
typedef unsigned short bf16;
typedef unsigned v4u __attribute__((ext_vector_type(4)));
typedef float f32x4 __attribute__((ext_vector_type(4)));
typedef short bf16x8 __attribute__((ext_vector_type(8)));
typedef GAS unsigned gu32;
typedef GAS unsigned long long gu64;
#define RLX_AGENT __ATOMIC_RELAXED, __HIP_MEMORY_SCOPE_AGENT
#define LDS_WAIT() asm volatile("s_waitcnt lgkmcnt(0)" ::: "memory")
#define VM_WAIT() asm volatile("s_waitcnt vmcnt(0)" ::: "memory")
__device__ __forceinline__ unsigned long long rt() { return __builtin_amdgcn_s_memrealtime(); }
__device__ __forceinline__ unsigned f2bf(float f) { unsigned u = __builtin_bit_cast(unsigned, f); return (u + 0x7fffu + ((u >> 16) & 1u)) >> 16; }
__device__ __forceinline__ unsigned pk2(float lo, float hi) { return f2bf(lo) | (f2bf(hi) << 16); }

#define XB_TMO      128
#define XB_XCNT(j)  (256  + 64 * (j))
#define XB_XSUB(j)  (1280 + 64 * (j))
#define XB_XGEN(j)  (2304 + 64 * (j))
#define XB_TOP      3328
#define XB_TOPGEN   3392
#define XCD_BAR_WORDS 3456
#define XB_SPIN_CAP (1u << 18)

__device__ __forceinline__ unsigned xb_ld(unsigned* p)              { return __hip_atomic_load(p, __ATOMIC_RELAXED, __HIP_MEMORY_SCOPE_AGENT); }
__device__ __forceinline__ unsigned xb_add(unsigned* p, unsigned v) { return __hip_atomic_fetch_add(p, v, __ATOMIC_RELAXED, __HIP_MEMORY_SCOPE_AGENT); }
__device__ __forceinline__ unsigned xb_xcc_id() { return (unsigned)__builtin_amdgcn_s_getreg((3 << 11) | 20) & 0xFu; }
#define XB_SPIN(cond, bar) do { unsigned _sp = 0; while (cond) { __builtin_amdgcn_s_sleep(1); \
    if ((++_sp & 255u) == 0u) { if (xb_ld(&(bar)[XB_TMO])) break; if (_sp > XB_SPIN_CAP) { atomicAdd(&(bar)[XB_TMO], 1u); break; } } } } while (0)

struct XcdBarrier {
    unsigned* bar; unsigned x;
    volatile LAS unsigned* st;
};

__device__ __forceinline__ XcdBarrier xcd_barrier_post(unsigned* bar, volatile LAS unsigned* st) {
    XcdBarrier b; b.bar = bar; b.x = xb_xcc_id(); b.st = st;
    if (threadIdx.x == 0) (void)xb_add(&bar[XB_XCNT(b.x)], 1u);
    return b;
}
__device__ __forceinline__ void xcd_barrier_complete(unsigned* bar, unsigned x, unsigned& nloc, unsigned& nx) {
    const unsigned G = gridDim.x * gridDim.y * gridDim.z;
    unsigned sum, cnt, mine, sp = 0u;
    for (;;) {
        sum = 0u; cnt = 0u; mine = 0u;
#pragma unroll
        for (unsigned j = 0; j < 16; ++j) { const unsigned c = xb_ld(&bar[XB_XCNT(j)]); sum += c; cnt += (c > 0u) ? 1u : 0u; mine = (j == x) ? c : mine; }
        if (sum == G) break;
        __builtin_amdgcn_s_sleep(1);
        if ((++sp & 255u) == 0u) { if (xb_ld(&bar[XB_TMO])) break; if (sp > XB_SPIN_CAP) { atomicAdd(&bar[XB_TMO], 1u); break; } }
    }
    nloc = mine > 0u ? mine : 1u; nx = cnt > 0u ? cnt : 1u;
}

__device__ __forceinline__ void xcd_barrier(const XcdBarrier& b) {
    asm volatile("s_waitcnt vmcnt(0)" ::: "memory");
    __syncthreads();
    if (threadIdx.x == 0) {
        unsigned* bar = b.bar;
        __builtin_amdgcn_s_waitcnt(0);
        unsigned nloc = b.st[0], nx = b.st[1];
        if (nloc == 0u) { xcd_barrier_complete(bar, b.x, nloc, nx); b.st[0] = nloc; b.st[1] = nx; }
        const unsigned old = xb_add(&bar[XB_XSUB(b.x)], 1u);
        const unsigned gen = old / nloc;
        if (old + 1u == (gen + 1u) * nloc) {
            __builtin_amdgcn_fence(__ATOMIC_RELEASE, "agent");
            asm volatile("s_waitcnt vmcnt(0)" ::: "memory");
            const unsigned og = xb_add(&bar[XB_TOP], 1u);
            const unsigned tg = og / nx;
            if (og + 1u == (tg + 1u) * nx) xb_add(&bar[XB_TOPGEN], 1u);
            else XB_SPIN(xb_ld(&bar[XB_TOPGEN]) == tg, bar);
            __builtin_amdgcn_fence(__ATOMIC_ACQUIRE, "agent");
            xb_add(&bar[XB_XGEN(b.x)], 1u);
            asm volatile("s_waitcnt vmcnt(0)" ::: "memory");
        } else {
            XB_SPIN(xb_ld(&bar[XB_XGEN(b.x)]) == gen, bar);
            __builtin_amdgcn_fence(__ATOMIC_ACQUIRE, "agent");
            asm volatile("s_waitcnt vmcnt(0)" ::: "memory");
        }
    }
    __syncthreads();
}
constexpr int NWAVES = 8;
constexpr int M = 16384, SEQ = 4096, DM = 1024, FF = 2816, INC = 2568, NMEM = 256;
constexpr float EPS = 1e-6f;
constexpr float LOG2E = 1.4426950408889634f;
constexpr float C2 = 0.125f * LOG2E, C2C = 0.0625f * LOG2E;
constexpr size_t MiB = 1u << 20;
constexpr size_t WS_CTL = 0, CTL_ZERO_BYTES = 1 * MiB;
constexpr size_t SS_OFF = 512 * 1024;
constexpr size_t WS_W1IN = 2 * MiB, WS_WCKV = 13 * MiB, WS_W1OUT = 17 * MiB, WS_WIN = 22 * MiB + 512 * 1024, WS_WOUT = 27 * MiB + 512 * 1024, WS_WCQ = 29 * MiB + 512 * 1024, WS_WCO = 31 * MiB + 512 * 1024,
                 WS_W2IN = 33 * MiB + 512 * 1024, WS_W2OUT = 44 * MiB + 512 * 1024;
constexpr size_t WS_XN = 50 * MiB, WS_MN = 82 * MiB, WS_KVRAW = 84 * MiB, WS_LOGF = 88 * MiB, WS_CUM = 88 * MiB + 512 * 1024;
constexpr size_t WS_Y = 90 * MiB, WS_ACT = 122 * MiB;
constexpr size_t WS_Q = 122 * MiB, WS_K = 138 * MiB, WS_V = 154 * MiB, WS_U = 170 * MiB, WS_VG = 186 * MiB, WS_QC = 122 * MiB, WS_OC = 170 * MiB, WS_KC = 202 * MiB, WS_VT = 204 * MiB, WS_END = 210 * MiB;
static_assert(WS_WCKV == WS_W1IN + (size_t)2 * FF * DM * 2, "Wckv copy must follow W1in copy (combined GEMM phase)");
static_assert(WS_MN == WS_XN + (size_t)M * DM * 2, "MN must follow XN (combined GEMM phase)");
constexpr int CW_BAR = 4096;
constexpr int RING_OFF = 0, LDSCTL_OFF = 139264, MISC_OFF = LDSCTL_OFF + 320, LDS_BYTES = 143360;
static_assert(attn_body::ATTN_LDS_BYTES <= LDSCTL_OFF && pg8::STAGE_BYTES <= LDSCTL_OFF, "LDS map");

struct Frame {
    LAS unsigned char* lds; volatile LAS unsigned* MISC; gu32* ctl;
    int tid, lane, wave, vcu, G;
};
struct Args { const float* in[26]; float* out; unsigned char* ws; int ph_lo, ph_hi, li, pad; };

__device__ __forceinline__ float wave_sum(float v) {
#pragma unroll
    for (int o = 1; o < 64; o <<= 1) v += __shfl_xor(v, o);
    return v;
}
__device__ __forceinline__ void p0_transpose_item(const float* W, int ldw, int K, int src_col0, bf16* WT, int dst_row0, LAS float* scr, int kb, int lane) {
    const int k0 = 64 * kb;
#pragma unroll 8
    for (int i = 0; i < 32; ++i) { const int kk = 2 * i + (lane >> 5); scr[kk * 33 + (lane & 31)] = W[(size_t)(k0 + kk) * ldw + src_col0 + (lane & 31)]; }
    LDS_WAIT(); asm volatile("" ::: "memory");
    const int c = lane & 7;
#pragma unroll
    for (int j = 0; j < 4; ++j) { const int n = (lane >> 3) + 8 * j; const LAS float* s = scr + (8 * c) * 33 + n;
        v4u o; o.x = pk2(s[0 * 33], s[1 * 33]); o.y = pk2(s[2 * 33], s[3 * 33]); o.z = pk2(s[4 * 33], s[5 * 33]); o.w = pk2(s[6 * 33], s[7 * 33]);
        *(GAS v4u*)(WT + (size_t)(dst_row0 + n) * K + k0 + 8 * c) = o; }
    LDS_WAIT(); asm volatile("" ::: "memory");
}
__device__ __forceinline__ int ffn_src_col(int db) { const int pn = db >> 3, w = db & 7; return (w >> 2) * FF + 128 * pn + 32 * (w & 3); }
__device__ __forceinline__ int mix_src_col(int db) { const int pn = db >> 3, w = db & 7;
    if (pn < 4) return (pn < 2 ? 0 : 512) + 256 * (pn & 1) + 64 * (w & 3) + 32 * (w >> 2);
    if (pn < 6) return 1024 + 256 * (pn - 4) + 32 * w;
    return 1544 + 256 * (pn - 6) + 32 * w; }
__device__ __forceinline__ void rms_row_to_bf16(int lane, const float* xrow, const float* g, bf16* orow) {
    const GAS f32x4* xr = (const GAS f32x4*)xrow + lane; const GAS f32x4* gr = (const GAS f32x4*)g + lane;
    f32x4 v[4]; float s = 0.f;
#pragma unroll
    for (int j = 0; j < 4; ++j) { v[j] = xr[64 * j]; s += (v[j].x * v[j].x + v[j].y * v[j].y) + (v[j].z * v[j].z + v[j].w * v[j].w); }
    const float rstd = rsqrtf(wave_sum(s) * (1.f / DM) + EPS);
    GAS unsigned long long* o8 = (GAS unsigned long long*)orow + lane;
#pragma unroll
    for (int j = 0; j < 4; ++j) { const f32x4 gg = gr[64 * j]; o8[64 * j] = (unsigned long long)pk2(v[j].x * rstd * gg.x, v[j].y * rstd * gg.y) | ((unsigned long long)pk2(v[j].z * rstd * gg.z, v[j].w * rstd * gg.w) << 32); }
}
__device__ __forceinline__ void p0_prologue(Frame& F, const Args& a) {
    LAS float* scr = (LAS float*)(F.lds + RING_OFF + F.wave * 16384);
    const int gw = F.vcu * NWAVES + F.wave, NGW = F.G * NWAVES;
    unsigned char* ws = a.ws;
    constexpr int I0 = 16 * 176, I1 = 16 * 64, I2 = 44 * 32, I3 = 16 * 80, I4 = 16 * 32;
    constexpr int NITEMS = 2 * I0 + I1 + 2 * I2 + I3 + 3 * I4;
    for (int it = gw; it < NITEMS; it += NGW) {
        int r = it;
        if (r < I0) { const int kb = r / 176, db = r % 176; p0_transpose_item(a.in[3], 2 * FF, DM, ffn_src_col(db), (bf16*)(ws + WS_W1IN), 32 * db, scr, kb, F.lane); continue; } r -= I0;
        if (r < I1) { const int kb = r / 64, db = r % 64; p0_transpose_item(a.in[19], 2048, DM, 32 * db, (bf16*)(ws + WS_WCKV), 32 * db, scr, kb, F.lane); continue; } r -= I1;
        if (r < I2) { const int kb = r / 32, db = r % 32; p0_transpose_item(a.in[4], DM, FF, 32 * db, (bf16*)(ws + WS_W1OUT), 32 * db, scr, kb, F.lane); continue; } r -= I2;
        if (r < I3) { const int kb = r / 80, db = r % 80; p0_transpose_item(a.in[6], INC, DM, mix_src_col(db), (bf16*)(ws + WS_WIN), 32 * db, scr, kb, F.lane); continue; } r -= I3;
        if (r < I4) { const int kb = r / 32, db = r % 32; p0_transpose_item(a.in[15], DM, DM, 32 * db, (bf16*)(ws + WS_WOUT), 32 * db, scr, kb, F.lane); continue; } r -= I4;
        if (r < I4) { const int kb = r / 32, db = r % 32; p0_transpose_item(a.in[18], DM, DM, 32 * db, (bf16*)(ws + WS_WCQ), 32 * db, scr, kb, F.lane); continue; } r -= I4;
        if (r < I4) { const int kb = r / 32, db = r % 32; p0_transpose_item(a.in[22], DM, DM, 32 * db, (bf16*)(ws + WS_WCO), 32 * db, scr, kb, F.lane); continue; } r -= I4;
        if (r < I0) { const int kb = r / 176, db = r % 176; p0_transpose_item(a.in[24], 2 * FF, DM, ffn_src_col(db), (bf16*)(ws + WS_W2IN), 32 * db, scr, kb, F.lane); continue; } r -= I0;
        { const int kb = r / 32, db = r % 32; p0_transpose_item(a.in[25], DM, FF, 32 * db, (bf16*)(ws + WS_W2OUT), 32 * db, scr, kb, F.lane); }
    }
    bf16* XN = (bf16*)(ws + WS_XN);
    for (int m = gw; m < M + 1024; m += NGW) {
        if (m < M) rms_row_to_bf16(F.lane, a.in[0] + (size_t)m * DM, a.in[2], XN + (size_t)m * DM);
        else rms_row_to_bf16(F.lane, a.in[1] + (size_t)(m - M) * DM, a.in[17], XN + (size_t)m * DM);
    }
}
__device__ __forceinline__ void p3_prelude(Frame& F, const Args& a) {
    unsigned char* ws = a.ws; const int gw = F.vcu * NWAVES + F.wave, lane = F.lane;
    const bf16* XN = (const bf16*)(ws + WS_XN); const float* ss2 = (const float*)(ws + SS_OFF); float* LOGF = (float*)(ws + WS_LOGF);
    {
        f32x4 wf[16][2];
        const float* wp = a.in[6] + (size_t)(16 * lane) * INC + 1536;
#pragma unroll
        for (int kk = 0; kk < 16; ++kk) { wf[kk][0] = *(const f32x4*)(wp + (size_t)kk * INC); wf[kk][1] = *(const f32x4*)(wp + (size_t)kk * INC + 4); }
        const float bfl = a.in[7][lane & 7];
        for (int m = gw; m < M; m += F.G * NWAVES) {
            const v4u x0 = *(const GAS v4u*)(XN + (size_t)m * DM + 16 * lane), x1 = *(const GAS v4u*)(XN + (size_t)m * DM + 16 * lane + 8);
            f32x4 d0 = {0.f, 0.f, 0.f, 0.f}, d1 = {0.f, 0.f, 0.f, 0.f};
#pragma unroll
            for (int e = 0; e < 4; ++e) { const float lo = __uint_as_float(x0[e] << 16), hi = __uint_as_float(x0[e] & 0xffff0000u);
                d0 += wf[2 * e][0] * lo + wf[2 * e + 1][0] * hi; d1 += wf[2 * e][1] * lo + wf[2 * e + 1][1] * hi; }
#pragma unroll
            for (int e = 0; e < 4; ++e) { const float lo = __uint_as_float(x1[e] << 16), hi = __uint_as_float(x1[e] & 0xffff0000u);
                d0 += wf[8 + 2 * e][0] * lo + wf[8 + 2 * e + 1][0] * hi; d1 += wf[8 + 2 * e][1] * lo + wf[8 + 2 * e + 1][1] * hi; }
#pragma unroll
            for (int h = 0; h < 4; ++h) { d0[h] = wave_sum(d0[h]); d1[h] = wave_sum(d1[h]); }
            const int hsel = lane & 7;
            float mine = d0[0];
            mine = hsel == 1 ? d0[1] : mine; mine = hsel == 2 ? d0[2] : mine; mine = hsel == 3 ? d0[3] : mine;
            mine = hsel == 4 ? d1[0] : mine; mine = hsel == 5 ? d1[1] : mine; mine = hsel == 6 ? d1[2] : mine; mine = hsel == 7 ? d1[3] : mine;
            const float y = mine * rsqrtf(ss2[m] * (1.f / DM) + EPS) + bfl;
            const float lf = fminf(y, 0.f) - log1pf(expf(-fabsf(y)));
            if (lane < 8) LOGF[(size_t)((m >> 12) * 8 + lane) * SEQ + (m & 4095)] = lf;
        }
    }
    const bf16* KV = (const bf16*)(ws + WS_KVRAW); bf16* KC = (bf16*)(ws + WS_KC); bf16* VT = (bf16*)(ws + WS_VT);
    for (int task = gw; task < 4096; task += F.G * NWAVES) {
        const int mr = task >> 2, h = task & 3; const unsigned long long raw = *(const GAS unsigned long long*)(KV + (size_t)mr * 2048 + h * 256 + 4 * lane);
        const float v0 = __uint_as_float((unsigned)raw << 16), v1 = __uint_as_float((unsigned)raw & 0xffff0000u), v2 = __uint_as_float((unsigned)(raw >> 32) << 16), v3 = __uint_as_float((unsigned)(raw >> 32) & 0xffff0000u);
        const float rs = rsqrtf(wave_sum((v0 * v0 + v1 * v1) + (v2 * v2 + v3 * v3)) * (1.f / 256.f) + EPS); const f32x4 g = *(const f32x4*)(a.in[21] + 4 * lane);
        *(GAS unsigned long long*)(KC + (size_t)mr * DM + h * 256 + 4 * lane) = (unsigned long long)pk2(v0 * rs * g.x, v1 * rs * g.y) | ((unsigned long long)pk2(v2 * rs * g.z, v3 * rs * g.w) << 32);
    }
    for (int L = gw * 64 + lane; L < 131072; L += F.G * NWAVES * 64) {
        const int c = L & 1023, j0 = ((L >> 10) & 31) * 8, b = L >> 15; v4u o;
#pragma unroll
        for (int i = 0; i < 4; ++i) o[i] = (unsigned)KV[(size_t)(b * 256 + j0 + 2 * i) * 2048 + 1024 + c] | ((unsigned)KV[(size_t)(b * 256 + j0 + 2 * i + 1) * 2048 + 1024 + c] << 16);
        *(GAS v4u*)(VT + (size_t)(b * 1024 + c) * 256 + j0) = o;
    }
}
__device__ __forceinline__ void sgu_phase(Frame& F, const Args& a) {
    unsigned char* ws = a.ws; int tid = threadIdx.x; asm volatile("" : "+v"(tid));
    const int lane = tid & 63, wid = __builtin_amdgcn_readfirstlane(tid >> 6), fr = lane & 15, kq = lane >> 4;
    constexpr int RS = 272;
    LAS unsigned char* Wt = F.lds; LAS unsigned char* Vt = F.lds + 128 * RS;
    const int g = F.vcu & 7;
    const bf16* U = (const bf16*)(ws + WS_U); const bf16* VG = (const bf16*)(ws + WS_VG); const float* ssv = (const float*)(ws + SS_OFF) + M; float* ssg = (float*)(ws + SS_OFF) + 3 * M; bf16* Y = (bf16*)(ws + WS_Y);
    {
        const int t = tid >> 2, s0 = (tid & 3) * 32; const float* wp = a.in[11] + (size_t)(g * 128 + t) * 128 + s0;
#pragma unroll
        for (int q = 0; q < 4; ++q) { const f32x4 x0 = *(const f32x4*)(wp + 8 * q), x1 = *(const f32x4*)(wp + 8 * q + 4); const int s = s0 + 8 * q; v4u o;
            o.x = pk2(s + 0 <= t ? x0.x : 0.f, s + 1 <= t ? x0.y : 0.f); o.y = pk2(s + 2 <= t ? x0.z : 0.f, s + 3 <= t ? x0.w : 0.f);
            o.z = pk2(s + 4 <= t ? x1.x : 0.f, s + 5 <= t ? x1.y : 0.f); o.w = pk2(s + 6 <= t ? x1.z : 0.f, s + 7 <= t ? x1.w : 0.f);
            *(LAS v4u*)(Wt + t * RS + s * 2) = o; }
    }
    for (int ui = 0; ui < 4; ++ui) {
        const int bc = (F.vcu >> 3) * 4 + ui, row0 = bc * 128;
        {
            const int s = tid >> 2, d0 = (tid & 3) * 16; const float rs = rsqrtf(ssv[row0 + s] * (1.f / 512.f) + EPS);
            const v4u x0 = *(const GAS v4u*)(VG + (size_t)(row0 + s) * 512 + g * 64 + d0), x1 = *(const GAS v4u*)(VG + (size_t)(row0 + s) * 512 + g * 64 + d0 + 8);
            const float* gp = a.in[10] + g * 64 + d0;
#pragma unroll
            for (int e = 0; e < 4; ++e) { const float lo = __uint_as_float(x0[e] << 16) * rs * gp[2 * e], hi = __uint_as_float(x0[e] & 0xffff0000u) * rs * gp[2 * e + 1];
                *(LAS unsigned short*)(Vt + (d0 + 2 * e) * RS + s * 2) = (unsigned short)f2bf(lo); *(LAS unsigned short*)(Vt + (d0 + 2 * e + 1) * RS + s * 2) = (unsigned short)f2bf(hi); }
#pragma unroll
            for (int e = 0; e < 4; ++e) { const float lo = __uint_as_float(x1[e] << 16) * rs * gp[8 + 2 * e], hi = __uint_as_float(x1[e] & 0xffff0000u) * rs * gp[8 + 2 * e + 1];
                *(LAS unsigned short*)(Vt + (d0 + 8 + 2 * e) * RS + s * 2) = (unsigned short)f2bf(lo); *(LAS unsigned short*)(Vt + (d0 + 8 + 2 * e + 1) * RS + s * 2) = (unsigned short)f2bf(hi); }
        }
        __syncthreads();
        f32x4 acc[4];
#pragma unroll
        for (int ib = 0; ib < 4; ++ib) acc[ib] = (f32x4){0.f, 0.f, 0.f, 0.f};
#pragma unroll
        for (int ks = 0; ks < 4; ++ks) { const bf16x8 wfr = *(const LAS bf16x8*)(Wt + (16 * wid + fr) * RS + (32 * ks + 8 * kq) * 2);
#pragma unroll
            for (int ib = 0; ib < 4; ++ib) { const bf16x8 vfr = *(const LAS bf16x8*)(Vt + (16 * ib + fr) * RS + (32 * ks + 8 * kq) * 2); acc[ib] = __builtin_amdgcn_mfma_f32_16x16x32_bf16(vfr, wfr, acc[ib], 0, 0, 0); } }
        const int t = 16 * wid + fr, row = row0 + t; const float bias = a.in[12][g * 128 + t]; float sq = 0.f;
#pragma unroll
        for (int ib = 0; ib < 4; ++ib) { const int c = g * 64 + 16 * ib + 4 * kq; const unsigned long long uu = *(const GAS unsigned long long*)(U + (size_t)row * 512 + c);
            const float u0 = __uint_as_float((unsigned)uu << 16), u1 = __uint_as_float((unsigned)uu & 0xffff0000u), u2 = __uint_as_float((unsigned)(uu >> 32) << 16), u3 = __uint_as_float((unsigned)(uu >> 32) & 0xffff0000u);
            const float s0 = u0 * (acc[ib][0] + bias), s1 = u1 * (acc[ib][1] + bias), s2 = u2 * (acc[ib][2] + bias), s3 = u3 * (acc[ib][3] + bias); sq += (s0 * s0 + s1 * s1) + (s2 * s2 + s3 * s3);
            const f32x4 go = *(const f32x4*)(a.in[14] + c);
            *(GAS unsigned long long*)(Y + (size_t)row * 1024 + 512 + c) = (unsigned long long)pk2(s0 * go.x, s1 * go.y) | ((unsigned long long)pk2(s2 * go.z, s3 * go.w) << 32); }
        sq += __shfl_xor(sq, 16); sq += __shfl_xor(sq, 32); if (kq == 0) atomicAdd(ssg + row, sq);
        __syncthreads();
    }
}
__device__ __forceinline__ void xattn_phase(Frame& F, const Args& a) {
    typedef short s16x4 __attribute__((ext_vector_type(4)));
    unsigned char* ws = a.ws; const int tid = F.tid, lane = F.lane, wid = F.wave, fr = lane & 15, kq = lane >> 4;
    constexpr int RS = 528;
    LAS unsigned char* L = F.lds;
    const bf16* QC = (const bf16*)(ws + WS_QC); const bf16* KC = (const bf16*)(ws + WS_KC); const bf16* VT = (const bf16*)(ws + WS_VT); bf16* OC = (bf16*)(ws + WS_OC);
    for (int ui = 0; ui < 2; ++ui) {
        const int unit = F.vcu * 2 + ui; if (unit >= 512) break;
        const int bh = unit >> 5, qb = unit & 31, b = bh >> 2, h = bh & 3; const int row0 = b * SEQ + qb * 128 + wid * 16;
        bf16x8 qf[8];
#pragma unroll
        for (int ks = 0; ks < 8; ++ks) qf[ks] = *(const GAS bf16x8*)(QC + (size_t)(row0 + fr) * DM + h * 256 + 32 * ks + 8 * kq);
#pragma unroll 4
        for (int i = 0; i < 16; ++i) { const int ch = tid + 512 * i, j = ch >> 5, c16 = ch & 31; *(LAS v4u*)(L + j * RS + c16 * 16) = *(const GAS v4u*)(KC + (size_t)(b * NMEM + j) * DM + h * 256 + c16 * 8); }
        __syncthreads();
        f32x4 s[16];
#pragma unroll
        for (int blk = 0; blk < 16; ++blk) { f32x4 acc = {0.f, 0.f, 0.f, 0.f};
#pragma unroll
            for (int ks = 0; ks < 8; ++ks) { const bf16x8 kfr = *(const LAS bf16x8*)(L + (16 * blk + fr) * RS + (32 * ks + 8 * kq) * 2); acc = __builtin_amdgcn_mfma_f32_16x16x32_bf16(kfr, qf[ks], acc, 0, 0, 0); }
            s[blk] = acc; }
        float mx = -INFINITY;
#pragma unroll
        for (int blk = 0; blk < 16; ++blk) mx = fmaxf(mx, fmaxf(fmaxf(s[blk][0], s[blk][1]), fmaxf(s[blk][2], s[blk][3])));
        mx = fmaxf(mx, __shfl_xor(mx, 16)); mx = fmaxf(mx, __shfl_xor(mx, 32));
        float sum = 0.f;
#pragma unroll
        for (int blk = 0; blk < 16; ++blk)
#pragma unroll
            for (int e = 0; e < 4; ++e) { s[blk][e] = __builtin_amdgcn_exp2f(s[blk][e] - mx); sum += s[blk][e]; }
        sum += __shfl_xor(sum, 16); sum += __shfl_xor(sum, 32);
        const float inv = 1.f / sum;
        bf16x8 pf[8];
#pragma unroll
        for (int k2 = 0; k2 < 8; ++k2) { const v4u w = {pk2(s[2 * k2][0], s[2 * k2][1]), pk2(s[2 * k2][2], s[2 * k2][3]), pk2(s[2 * k2 + 1][0], s[2 * k2 + 1][1]), pk2(s[2 * k2 + 1][2], s[2 * k2 + 1][3])}; pf[k2] = __builtin_bit_cast(bf16x8, w); }
        __syncthreads();
#pragma unroll 4
        for (int i = 0; i < 16; ++i) { const int ch = tid + 512 * i, d = ch >> 5, c16 = ch & 31; *(LAS v4u*)(L + d * RS + c16 * 16) = *(const GAS v4u*)(VT + (size_t)(b * 1024 + h * 256 + d) * NMEM + c16 * 8); }
        __syncthreads();
#pragma unroll 2
        for (int db = 0; db < 16; ++db) { f32x4 acc = {0.f, 0.f, 0.f, 0.f};
#pragma unroll
            for (int k2 = 0; k2 < 8; ++k2) { const s16x4 lo = *(const LAS s16x4*)(L + (16 * db + fr) * RS + (32 * k2 + 4 * kq) * 2), hi = *(const LAS s16x4*)(L + (16 * db + fr) * RS + (32 * k2 + 16 + 4 * kq) * 2);
                const bf16x8 vfr = {lo[0], lo[1], lo[2], lo[3], hi[0], hi[1], hi[2], hi[3]}; acc = __builtin_amdgcn_mfma_f32_16x16x32_bf16(vfr, pf[k2], acc, 0, 0, 0); }
            *(GAS unsigned long long*)(OC + (size_t)(row0 + fr) * DM + h * 256 + 16 * db + 4 * kq) = (unsigned long long)pk2(acc[0] * inv, acc[1] * inv) | ((unsigned long long)pk2(acc[2] * inv, acc[3] * inv) << 32); }
        __syncthreads();
    }
}
__global__ void __launch_bounds__(NWAVES * 64, 2) mk_fwd(Args args) {
    extern __shared__ __attribute__((aligned(16))) unsigned char lds[];
    Frame F;
    F.lds = (LAS unsigned char*)lds; F.MISC = (volatile LAS unsigned*)(F.lds + MISC_OFF);
    F.tid = threadIdx.x; F.lane = F.tid & 63; F.wave = __builtin_amdgcn_readfirstlane(F.tid >> 6);
    F.G = gridDim.x; { const int bx = blockIdx.x; F.vcu = (F.G % 8 == 0) ? (bx % 8) * (F.G / 8) + bx / 8 : bx; }
    unsigned char* ws = args.ws; F.ctl = (gu32*)(ws + WS_CTL);
    for (int u = F.tid; u < (LDS_BYTES - LDSCTL_OFF) / 4; u += NWAVES * 64) ((LAS unsigned*)(F.lds + LDSCTL_OFF))[u] = 0u;
    __syncthreads();
    XcdBarrier bar = xcd_barrier_post((unsigned*)(F.ctl + CW_BAR) + args.li * XCD_BAR_WORDS, F.MISC + 8);
    const int lo = args.ph_lo, hi = args.ph_hi;
#ifndef PH_MASK
#define PH_MASK 0x7ff
#endif
#define IN(k) ((((PH_MASK) >> (k)) & 1) && lo <= (k) && (k) < hi)
#define SEAM(k) do { if (IN(k) && IN((k) + 1)) xcd_barrier(bar); } while (0)
    float* ssb = (float*)(ws + SS_OFF); float *ss2 = ssb, *ssv = ssb + M, *ssa = ssb + 2 * M, *ssg = ssb + 3 * M, *ss3 = ssb + 4 * M, *ss4 = ssb + 5 * M;
    pg8::bf16_t* XN = (pg8::bf16_t*)(ws + WS_XN); pg8::bf16_t* ACT = (pg8::bf16_t*)(ws + WS_ACT); pg8::bf16_t* Y = (pg8::bf16_t*)(ws + WS_Y);
    float* out = args.out;
    const int bid = (int)blockIdx.x;

    if (IN(0)) { p0_prologue(F, args); SEAM(0); }
    if (IN(1)) {
        pg8::Gemm g{XN, (const pg8::bf16_t*)(ws + WS_W1IN), M + 1024, 2 * FF + 2048, DM}; pg8::ComboOrder S; S.init(M, 2 * FF, F.G, bid, 32, 64, 22, 4);
        pg8::EpiSwiGLU E{ACT, nullptr, (pg8::bf16_t*)(ws + WS_KVRAW), 22, 64};
        pg8::gemm_phase<pg8::EpiSwiGLU, pg8::ComboOrder, PG8_ALIGN, PG8_SP2>(F.lds + RING_OFF, g, S, E); SEAM(1); }
    if (IN(2)) {
        pg8::Gemm g{ACT, (const pg8::bf16_t*)(ws + WS_W1OUT), M, DM, FF}; pg8::StaticOrder S; S.init(M, DM, F.G, bid);
        pg8::EpiRes<0> E{args.in[0], out, 0.5f, nullptr, nullptr, args.in[5], XN, ss2};
        pg8::gemm_phase<pg8::EpiRes<0>, pg8::StaticOrder, PG8_ALIGN, PG8_SP2>(F.lds + RING_OFF, g, S, E); SEAM(2); }
    if (IN(3)) {
        p3_prelude(F, args);
        pg8::Gemm g{XN, (const pg8::bf16_t*)(ws + WS_WIN), M, 2560, DM}; pg8::StaticOrder S; S.init(M, 2560, F.G, bid);
        static_assert(WS_K - WS_Q == 16 * MiB && WS_V - WS_K == 16 * MiB && WS_U - WS_V == 16 * MiB && WS_VG - WS_U == 16 * MiB, "EpiMix addresses Q|K|V|U|VG by stride");
        pg8::EpiMix E{ss2, args.in[8], args.in[9], (pg8::bf16_t*)(ws + WS_Q), ssv};
        pg8::gemm_phase<pg8::EpiMix, pg8::StaticOrder, PG8_ALIGN, PG8_SP2>(F.lds + RING_OFF, g, S, E); SEAM(3); }
    if (IN(4)) {
        const attn_body::AttnTensors AT{(const attn_body::bf16*)(ws + WS_Q), (const attn_body::bf16*)(ws + WS_K), (const attn_body::bf16*)(ws + WS_V), (unsigned short*)Y, args.in[13], ssa, (const float*)(ws + WS_LOGF)};
        const attn_body::StaticOrder S((int)F.G, bid);
        sgu_phase(F, args);
        attn_body::attn_phase<attn_body::StaticOrder>((char*)lds + RING_OFF, AT, S); SEAM(4); }
    if (IN(5)) {
        pg8::Gemm g{Y, (const pg8::bf16_t*)(ws + WS_WOUT), M, DM, DM}; pg8::StaticOrder S; S.init(M, DM, F.G, bid);
        pg8::EpiRes<8> E{out, out, 1.0f, ssg, ssa, args.in[16], XN, ss3};
        pg8::gemm_phase<pg8::EpiRes<8>, pg8::StaticOrder, PG8_ALIGN, PG8_SP2>(F.lds + RING_OFF, g, S, E); SEAM(5); }
    if (IN(6)) {
        pg8::Gemm g{XN, (const pg8::bf16_t*)(ws + WS_WCQ), M, DM, DM}; pg8::StaticOrder S; S.init(M, DM, F.G, bid);
        pg8::EpiCQ E{ss3, args.in[20], (pg8::bf16_t*)(ws + WS_QC)};
        pg8::gemm_phase<pg8::EpiCQ, pg8::StaticOrder, false, PG8_SP2>(F.lds + RING_OFF, g, S, E); SEAM(6); }
    if (IN(7)) { xattn_phase(F, args); SEAM(7); }
    if (IN(8)) {
        pg8::Gemm g{(const pg8::bf16_t*)(ws + WS_OC), (const pg8::bf16_t*)(ws + WS_WCO), M, DM, DM}; pg8::StaticOrder S; S.init(M, DM, F.G, bid);
        pg8::EpiRes<0> E{out, out, 1.0f, nullptr, nullptr, args.in[23], XN, ss4};
        pg8::gemm_phase<pg8::EpiRes<0>, pg8::StaticOrder, PG8_ALIGN, PG8_SP2>(F.lds + RING_OFF, g, S, E); SEAM(8); }
    if (IN(9)) {
        pg8::Gemm g{XN, (const pg8::bf16_t*)(ws + WS_W2IN), M, 2 * FF, DM}; pg8::ComboOrder S; S.init(M, 2 * FF, F.G, bid, 0, 64, 22, 4);
        pg8::EpiSwiGLU E{ACT, ss4, nullptr, 22, 64};
        pg8::gemm_phase<pg8::EpiSwiGLU, pg8::ComboOrder, PG8_ALIGN, PG8_SP2>(F.lds + RING_OFF, g, S, E); SEAM(9); }
    if (IN(10)) {
        pg8::Gemm g{ACT, (const pg8::bf16_t*)(ws + WS_W2OUT), M, DM, FF}; pg8::StaticOrder S; S.init(M, DM, F.G, bid);
        pg8::EpiRes<0> E{out, out, 0.5f, nullptr, nullptr, nullptr, nullptr, nullptr};
        pg8::gemm_phase<pg8::EpiRes<0>, pg8::StaticOrder, PG8_ALIGN, PG8_SP2>(F.lds + RING_OFF, g, S, E); }
#undef IN
#undef SEAM
}
#ifndef FAST_K
#define FAST_K 11
#endif
extern "C" void kernel_launch(void* const* d_in, const int* in_sizes, int n_in, void* d_out, int out_size, void* d_ws, size_t ws_size, hipStream_t stream) {
    static int grid = 0;
    if (grid == 0) {
        if (n_in != 26 || in_sizes[0] != M * DM || out_size != M * DM || ws_size < WS_END) { fprintf(stderr, "kernel_launch: unexpected problem shape (n_in %d, in0 %d, out %d, ws %zu)\n", n_in, n_in > 0 ? in_sizes[0] : -1, out_size, ws_size); grid = -1; return; }
        int dev = 0, cus = 0, per_cu = 0;
        if (hipGetDevice(&dev) != hipSuccess || hipDeviceGetAttribute(&cus, hipDeviceAttributeMultiprocessorCount, dev) != hipSuccess) { grid = -1; return; }
        if (hipFuncSetAttribute((const void*)mk_fwd, hipFuncAttributeMaxDynamicSharedMemorySize, LDS_BYTES) != hipSuccess) { fprintf(stderr, "kernel_launch: hipFuncSetAttribute failed\n"); grid = -1; return; }
        if (hipOccupancyMaxActiveBlocksPerMultiprocessor(&per_cu, (const void*)mk_fwd, NWAVES * 64, LDS_BYTES) != hipSuccess || per_cu < 1) fprintf(stderr, "kernel_launch: occupancy query reports %d workgroups per CU\n", per_cu);
        (void)hipGetLastError();
        grid = cus;
        if (grid != 256) fprintf(stderr, "kernel_launch: %d CUs; this kernel's unit orders are built for 256\n", grid);
#if FAST_K < 11
        (void)hipFuncSetAttribute((const void*)nv::nv_ffn<true>, hipFuncAttributeMaxDynamicSharedMemorySize, 160 * 1024);
        (void)hipFuncSetAttribute((const void*)nv::nv_mixin, hipFuncAttributeMaxDynamicSharedMemorySize, 160 * 1024);
        (void)hipFuncSetAttribute((const void*)nv::nv_proj<0>, hipFuncAttributeMaxDynamicSharedMemorySize, 160 * 1024);
        (void)hipFuncSetAttribute((const void*)nv::nv_proj<1>, hipFuncAttributeMaxDynamicSharedMemorySize, 160 * 1024);
        (void)hipFuncSetAttribute((const void*)nv::nv_cq, hipFuncAttributeMaxDynamicSharedMemorySize, 160 * 1024);
        (void)hipFuncSetAttribute((const void*)nv::nv_kvmem, hipFuncAttributeMaxDynamicSharedMemorySize, 160 * 1024);
#endif
    }
    if (grid < 0) return;
    unsigned char* ws = (unsigned char*)d_ws;
    (void)hipMemsetAsync(ws + WS_CTL, 0, CTL_ZERO_BYTES, stream);
    Args a{};
    for (int i = 0; i < 26; ++i) a.in[i] = (const float*)d_in[i];
    a.out = (float*)d_out; a.ws = ws; a.ph_lo = 0; a.ph_hi = FAST_K; a.li = 0;
    hipLaunchKernelGGL(mk_fwd, dim3(grid), dim3(NWAVES * 64), LDS_BYTES, stream, a);
#if FAST_K < 11
    {
        using namespace nv;
        const float* const* in = a.in; float* out = a.out;
        float* ssb = (float*)(ws + SS_OFF); float *ss2 = ssb, *ssv = ssb + M, *ssa = ssb + 2 * M, *ssg = ssb + 3 * M, *ss3 = ssb + 4 * M, *ss4 = ssb + 5 * M;
        nv::bf16_t* XN = (nv::bf16_t*)(ws + WS_XN); nv::bf16_t* MN = (nv::bf16_t*)(ws + WS_MN); nv::bf16_t* KC = (nv::bf16_t*)(ws + WS_KC); nv::bf16_t* VT = (nv::bf16_t*)(ws + WS_VT);
        float* LOGF = (float*)(ws + WS_LOGF); float* CUM = (float*)(ws + WS_CUM); nv::bf16_t* Y = (nv::bf16_t*)(ws + WS_Y);
        nv::bf16_t *Q = (nv::bf16_t*)(ws + WS_Q), *K = (nv::bf16_t*)(ws + WS_K), *V = (nv::bf16_t*)(ws + WS_V), *U = (nv::bf16_t*)(ws + WS_U), *VG = (nv::bf16_t*)(ws + WS_VG), *QC = (nv::bf16_t*)(ws + WS_QC), *OC = (nv::bf16_t*)(ws + WS_OC);
        if (FAST_K <= 3) { nv_kvmem<<<1024 / 8, 256, (8 * 1024 + 8 * 2048) * 4, stream>>>(MN, in[19], in[21], KC, VT);
                           nv_mixin<<<M / 8, 256, (8 * 1024 + 8 * INC) * 4, stream>>>(XN, ss2, in[6], in[7], in[8], in[9], Q, K, V, U, VG, ssv, LOGF); }
        if (FAST_K <= 4) { nv_scan<<<32, 64, 0, stream>>>(LOGF, CUM); nv_fox<<<dim3(64, 32), 64, 0, stream>>>(Q, K, V, CUM, in[13], Y, ssa);
                           nv_sgu<<<1024, 256, 0, stream>>>(U, VG, ssv, in[10], in[11], in[12], in[14], Y, ssg); }
        if (FAST_K <= 5) nv_proj<0><<<M / 8, 256, (16 * 1024) * 4, stream>>>(Y, ssa, ssg, in[15], out, in[16], XN, ss3);
        if (FAST_K <= 6) nv_cq<<<M / 8, 256, (16 * 1024) * 4, stream>>>(XN, ss3, in[18], in[20], QC);
        if (FAST_K <= 7) nv_xattn<<<M, 256, 0, stream>>>(QC, KC, VT, OC);
        if (FAST_K <= 8) nv_proj<1><<<M / 8, 256, (16 * 1024) * 4, stream>>>(OC, nullptr, nullptr, in[22], out, in[23], XN, ss4);
        if (FAST_K <= 10) nv_ffn<true><<<M / 8, 256, (8 * 1024 + 8 * FF) * 4, stream>>>(XN, ss4, out, in[24], in[25], out, nullptr, nullptr, nullptr);
    }
#endif
}
```

```cpp
#include <hip/hip_runtime.h>
#include <hip/hip_bf16.h>
#include <cstdio>
#include <cstdint>
#include <cmath>
namespace pg8 {
#define PG8_LAS __attribute__((address_space(3)))
typedef unsigned short bf16_t;
typedef short bf16x8 __attribute__((ext_vector_type(8)));
typedef float f32x4 __attribute__((ext_vector_type(4)));
typedef unsigned u32x4 __attribute__((ext_vector_type(4)));
constexpr int BM = 256, BK = 64, HALF = 128, HTB = HALF * BK * 2  , STAGE_BYTES = 8 * HTB, NXCD = 8, WGM = 8;

__host__ __device__ __forceinline__ int lds_byte(int r, int c) { const int st = (r >> 4) * 2 + (c >> 5), rr = r & 15, cc = c & 31, ob = rr * 64 + cc * 2; return st * 1024 + (ob ^ (((ob >> 9) & 1) << 5)); }
__host__ __device__ __forceinline__ void stage_rc(int b, int& R, int& C) { const int st = b / 1024, sb = b % 1024, swz = sb ^ (((sb >> 9) & 1) << 5); R = (st >> 1) * 16 + swz / 64; C = (st & 1) * 32 + (swz % 64) / 2; }
__host__ __device__ __forceinline__ int perm32(int rho) { const int n = rho >> 4, i = rho & 15; return 8 * (i >> 2) + 4 * n + (i & 3); }

struct Unit { int pm, pn; };
__host__ __device__ __forceinline__ int unit_pn(const Unit& u) { return u.pn & 0xffff; }
__host__ __device__ __forceinline__ int unit_hm(const Unit& u) { return (u.pn >> 16) - 1; }
struct Gemm { const bf16_t* A; const bf16_t* Bt; int M, N, K; };

struct StaticOrder {
    int nM, nN, nwg, G, c;
    __host__ __device__ void init(int M, int N, int G_, int c_) { nM = M / BM; nN = N / BM; nwg = nM * nN; G = G_; c = c_; }
    __host__ __device__ __forceinline__ bool next(int i, Unit& u) const {
        const long L = (long)i * G + c; return at(L, u); }
    __host__ __device__ __forceinline__ bool at(long L, Unit& u) const {
        if (L >= nwg) return false;
        int wgid = (int)L; { const int q = nwg / NXCD, r = nwg % NXCD, xcd = wgid % NXCD, off = wgid / NXCD; wgid = (xcd < r ? xcd * (q + 1) : r * (q + 1) + (xcd - r) * q) + off; }
        const int nig = WGM * nN, gid = wgid / nig, fm = gid * WGM, gsz = (nM - fm) < WGM ? (nM - fm) : WGM;
        u.pm = fm + ((wgid % nig) % gsz); u.pn = (wgid % nig) / gsz; return true;
    }
    __device__ __forceinline__ void a_ready(const Unit&) const {}
    __device__ __forceinline__ void done(const Unit&) const {}
};
struct HalfTailOrder {
    StaticOrder so; int R;
    __host__ __device__ void init(int M, int N, int G_, int c_) { so.init(M, N, G_, c_); R = so.nwg / G_; }
    __host__ __device__ __forceinline__ bool next(int i, Unit& u) const {
        if (i < R) return so.next(i, u);
        if (i > R || (so.nwg - R * so.G) * 2 != so.G) return false;
        const int g = so.c & 7, k = so.c >> 3; const bool ok = so.at((long)R * so.G + g + 8 * (k >> 1), u); u.pn |= ((k & 1) + 1) << 16; return ok; }
    __device__ __forceinline__ void a_ready(const Unit&) const {}
    __device__ __forceinline__ void done(const Unit&) const {}
};

__device__ __forceinline__ unsigned cvt_pk_bf16(float lo, float hi) { unsigned r; asm volatile("v_cvt_pk_bf16_f32 %0, %1, %2" : "=v"(r) : "v"(lo), "v"(hi)); return r; }
typedef float f32x2 __attribute__((ext_vector_type(2)));
__device__ __forceinline__ f32x2 gelu_pk(f32x2 v) {
    const f32x2 av = __builtin_elementwise_abs(v), d = av * 0.2316418882f + 1.0f;
    f32x2 t; t.x = __builtin_amdgcn_rcpf(d.x); t.y = __builtin_amdgcn_rcpf(d.y);
    f32x2 q = t * 0.5307027145f + (-0.7265760135f); q = q * t + 0.7107068705f; q = q * t + (-0.142248368f); q = q * t + 0.127414796f; q = q * t;
    const f32x2 s = (v * v) * (-0.72134752044f);
    f32x2 e; e.x = __builtin_amdgcn_exp2f(s.x); e.y = __builtin_amdgcn_exp2f(s.y);
    const f32x2 m = v * (q * e), r = v - m;
    f32x2 o; o.x = v.x < 0.f ? m.x : r.x; o.y = v.y < 0.f ? m.y : r.y; return o;
}

template <int ACT  > struct EpiBf16 {
    static constexpr bool PERM = true, AFTER_DRAIN = false; static_assert(ACT == 0 || ACT == 1, "EpiBf16: ACT is 0 (none) or 1 (gelu_pk)");
    bf16_t* O; int ldc; const float* bias; int split_cols; size_t split_stride; float scale0;
    __device__ __forceinline__ void operator()(const f32x4 (&acc)[2][2][4][2], const Unit& u, int wr, int wc, int fr, int fq) const {
        const int row0 = u.pm * BM + wr * 64 + fr; int colt = u.pn * BM; bf16_t* base = O;
        float sc = 1.f; if (split_cols) { const int t = colt / split_cols; base += (size_t)t * split_stride; colt -= t * split_cols; if (t == 0) sc = scale0; }
        const int col0 = colt + wc * 32 + 8 * fq, bcol0 = u.pn * BM + wc * 32 + 8 * fq;
        f32x4 bv[2][2];
#pragma unroll
        for (int bj = 0; bj < 2; ++bj)
#pragma unroll
            for (int n = 0; n < 2; ++n) bv[bj][n] = bias ? *(const f32x4*)(bias + bcol0 + bj * HALF + 4 * n) : (f32x4){0.f, 0.f, 0.f, 0.f};
#pragma unroll
        for (int ai = 0; ai < 2; ++ai)
#pragma unroll
            for (int m = 0; m < 4; ++m) { bf16_t* rowp = base + (size_t)(row0 + ai * HALF + m * 16) * ldc + col0;
#pragma unroll
                for (int bj = 0; bj < 2; ++bj) { f32x4 v0 = acc[ai][bj][m][0] + bv[bj][0], v1 = acc[ai][bj][m][1] + bv[bj][1];
                    if (ACT == 1) { f32x2 a = gelu_pk((f32x2){v0[0], v0[1]}), b = gelu_pk((f32x2){v0[2], v0[3]}), c = gelu_pk((f32x2){v1[0], v1[1]}), d = gelu_pk((f32x2){v1[2], v1[3]});
                        v0 = (f32x4){a.x, a.y, b.x, b.y}; v1 = (f32x4){c.x, c.y, d.x, d.y}; }
                    v0 = v0 * sc; v1 = v1 * sc; u32x4 w; w.x = cvt_pk_bf16(v0[0], v0[1]); w.y = cvt_pk_bf16(v0[2], v0[3]); w.z = cvt_pk_bf16(v1[0], v1[1]); w.w = cvt_pk_bf16(v1[2], v1[3]);
                    *(u32x4*)(rowp + bj * HALF) = w; } }
    }
};
constexpr float K_EPS = 1e-6f, K_LOG2E = 1.4426950408889634f;
constexpr float K_C2 = 0.125f * K_LOG2E;
constexpr float K_C2C = 0.0625f * K_LOG2E;
__device__ __forceinline__ float silu_f(float x) { return x * __builtin_amdgcn_rcpf(1.f + __builtin_amdgcn_exp2f(-x * K_LOG2E)); }
__device__ __forceinline__ float gelu_tanh_f(float x) { const float z2 = x * (1.5957691216057308f + 0.0713548162726009f * x * x); return x * __builtin_amdgcn_rcpf(1.f + __builtin_amdgcn_exp2f(-z2 * K_LOG2E)); }
__device__ __forceinline__ u32x4 pack8(const f32x4 v0, const f32x4 v1) { u32x4 w; w.x = cvt_pk_bf16(v0[0], v0[1]); w.y = cvt_pk_bf16(v0[2], v0[3]); w.z = cvt_pk_bf16(v1[0], v1[1]); w.w = cvt_pk_bf16(v1[2], v1[3]); return w; }
#ifndef WT_STORES
#define WT_STORES 0
#endif
__device__ __forceinline__ void st16(void* p, u32x4 v) {
#if WT_STORES
    asm volatile("global_store_dwordx4 %0, %1, off sc1\n\ts_nop 1" :: "v"(p), "v"(v) : "memory");
#else
    *(u32x4*)p = v;
#endif
}
typedef unsigned u32x2_t __attribute__((ext_vector_type(2)));
__device__ __forceinline__ void st8(void* p, u32x2_t v) {
#if WT_STORES
    asm volatile("global_store_dwordx2 %0, %1, off sc1\n\ts_nop 1" :: "v"(p), "v"(v) : "memory");
#else
    *(u32x2_t*)p = v;
#endif
}
__device__ __forceinline__ void st16f(void* p, f32x4 v) { st16(p, __builtin_bit_cast(u32x4, v)); }
__device__ __forceinline__ float sumsq4(const f32x4 v) { return (v[0] * v[0] + v[1] * v[1]) + (v[2] * v[2] + v[3] * v[3]); }

struct ComboOrder {
    StaticOrder so; int nmain, nextra, xm0, xn0, xnm;
    __host__ __device__ void init(int M, int N, int G_, int c_, int nextra_, int xm0_, int xn0_, int xnm_) { so.init(M, N, G_, c_); nmain = so.nwg; nextra = nextra_; xm0 = xm0_; xn0 = xn0_; xnm = xnm_; }
    __host__ __device__ __forceinline__ bool next(int i, Unit& u) const {
        const long L = (long)i * so.G + so.c; if (L < nmain) return so.next(i, u);
        const int j = (int)(L - nmain); if (j >= nextra) return false; u.pm = xm0 + j % xnm; u.pn = xn0 + j / xnm; return true; }
    __device__ __forceinline__ void a_ready(const Unit&) const {}
    __device__ __forceinline__ void done(const Unit&) const {}
};

struct EpiSwiGLU {
    static constexpr bool PERM = true, AFTER_DRAIN = false; static constexpr int MIDK = 0;
    bf16_t* ACT; const float* ss; bf16_t* KV; int nmain_n, nmain_m;
    __device__ __forceinline__ void midk(f32x4 (&)[2][2][4][2], const Unit&, int, int) const {}
    __device__ __forceinline__ void operator()(const f32x4 (&acc)[2][2][4][2], const Unit& u, int wr, int wc, int fr, int fq) const {
        const int rowl = wr * 64 + fr;
        if (unit_pn(u) >= nmain_n) {
            const int col0 = (unit_pn(u) - nmain_n) * BM + wc * 32 + 8 * fq;
#pragma unroll
            for (int ai = 0; ai < 2; ++ai)
#pragma unroll
                for (int m = 0; m < 4; ++m) { bf16_t* rowp = KV + (size_t)((u.pm - nmain_m) * BM + rowl + ai * HALF + m * 16) * 2048 + col0;
#pragma unroll
                    for (int bj = 0; bj < 2; ++bj) st16(rowp + bj * HALF, pack8(acc[ai][bj][m][0], acc[ai][bj][m][1])); }
            return;
        }
        const int col0 = unit_pn(u) * HALF + wc * 32 + 8 * fq; const int hoff = unit_hm(u) > 0 ? HALF : 0, nai = unit_hm(u) < 0 ? 2 : 1;
#pragma unroll
        for (int ai = 0; ai < 2; ++ai) if (ai < nai)
#pragma unroll
            for (int m = 0; m < 4; ++m) { const int row = u.pm * BM + hoff + rowl + ai * HALF + m * 16; const float rs = ss ? rsqrtf(ss[row] * (1.f / 1024.f) + K_EPS) : 1.f;
                f32x4 h[2];
#pragma unroll
                for (int n = 0; n < 2; ++n) { const f32x4 g = acc[ai][0][m][n] * rs, uu = acc[ai][1][m][n] * rs;
#pragma unroll
                    for (int e = 0; e < 4; ++e) h[n][e] = silu_f(g[e]) * uu[e]; }
                st16(ACT + (size_t)row * 2816 + col0, pack8(h[0], h[1])); }
    }
};

template <int MIDK_, bool XRES_BF16, bool OUT_BF16> struct EpiRes {
    static constexpr bool PERM = true, AFTER_DRAIN = false; static constexpr int MIDK = MIDK_;
    const void* xres; void* out; float scale; const float* ss_row; const float* ss_mid; float* ss_out;
    __device__ __forceinline__ void midk(f32x4 (&acc)[2][2][4][2], const Unit& u, int wr, int fr) const {
        int rb = u.pm * BM + wr * 64 + fr; asm volatile("" : "+v"(rb));
#pragma unroll
        for (int ai = 0; ai < 2; ++ai)
#pragma unroll
            for (int m = 0; m < 4; ++m) { const int row = rb + ai * HALF + m * 16;
                const float f = sqrtf((ss_row[row] * (1.f / 512.f) + K_EPS) / (ss_mid[row] * (1.f / 512.f) + K_EPS));
#pragma unroll
                for (int bj = 0; bj < 2; ++bj)
#pragma unroll
                    for (int n = 0; n < 2; ++n) acc[ai][bj][m][n] *= f;
                asm volatile("" ::: "memory"); }
    }
    __device__ __forceinline__ void operator()(const f32x4 (&acc)[2][2][4][2], const Unit& u, int wr, int wc, int fr, int fq) const {
        const int col0 = u.pn * BM + wc * 32 + 8 * fq;
#pragma unroll
        for (int ai = 0; ai < 2; ++ai)
#pragma unroll
            for (int m = 0; m < 4; ++m) { const int row = u.pm * BM + wr * 64 + fr + ai * HALF + m * 16; const size_t off = (size_t)row * 1024 + col0;
                const float rsc = scale * (ss_row ? rsqrtf(ss_row[row] * (1.f / 512.f) + K_EPS) : 1.f); float sq = 0.f;
#pragma unroll
                for (int bj = 0; bj < 2; ++bj) { f32x4 x0, x1;
                    if (XRES_BF16) { const u32x4 r = *(const u32x4*)((const bf16_t*)xres + off + bj * HALF);
                        x0 = (f32x4){__uint_as_float(r.x << 16), __uint_as_float(r.x & 0xffff0000u), __uint_as_float(r.y << 16), __uint_as_float(r.y & 0xffff0000u)};
                        x1 = (f32x4){__uint_as_float(r.z << 16), __uint_as_float(r.z & 0xffff0000u), __uint_as_float(r.w << 16), __uint_as_float(r.w & 0xffff0000u)}; }
                    else { x0 = __builtin_nontemporal_load((const f32x4*)((const float*)xres + off + bj * HALF)); x1 = __builtin_nontemporal_load((const f32x4*)((const float*)xres + off + bj * HALF + 4)); }
                    const f32x4 o0 = x0 + acc[ai][bj][m][0] * rsc, o1 = x1 + acc[ai][bj][m][1] * rsc;
                    if (OUT_BF16) st16((bf16_t*)out + off + bj * HALF, pack8(o0, o1));
                    else { __builtin_nontemporal_store(o0, (f32x4*)((float*)out + off + bj * HALF)); __builtin_nontemporal_store(o1, (f32x4*)((float*)out + off + bj * HALF + 4)); }
                    if (ss_out) sq += sumsq4(o0) + sumsq4(o1); }
                if (ss_out) { sq += __shfl_xor(sq, 16); sq += __shfl_xor(sq, 32); if (fq == 0) atomicAdd(ss_out + row, sq); } }
    }
};

struct EpiMix {
    static constexpr bool PERM = true, AFTER_DRAIN = false; static constexpr int MIDK = 0;
    const float* ss2; const float* g_q; const float* g_k; bf16_t* QB; float* ssv;
    __device__ __forceinline__ void midk(f32x4 (&)[2][2][4][2], const Unit&, int, int) const {}
    __device__ __forceinline__ void operator()(const f32x4 (&acc)[2][2][4][2], const Unit& u, int wr, int wc, int fr, int fq) const {
        const int pn = unit_pn(u), rowl = wr * 64 + fr; const int hoff = unit_hm(u) > 0 ? HALF : 0, nai = unit_hm(u) < 0 ? 2 : 1;
        if (pn < 4) {
            const float* g = pn < 2 ? g_q : g_k; bf16_t* dst = QB + (size_t)(pn >> 1) * (8u << 20); const float sc = pn < 2 ? K_C2 : 1.f; const int cb = (pn & 1) * 256 + 64 * wc + 8 * fq;
            f32x4 gv[2][2];
#pragma unroll
            for (int bj = 0; bj < 2; ++bj)
#pragma unroll
                for (int n = 0; n < 2; ++n) gv[bj][n] = *(const f32x4*)(g + 32 * bj + 8 * fq + 4 * n) * sc;
#pragma unroll
            for (int ai = 0; ai < 2; ++ai) if (ai < nai)
#pragma unroll
                for (int m = 0; m < 4; ++m) { const int row = u.pm * BM + hoff + rowl + ai * HALF + m * 16; const float rs2 = rsqrtf(ss2[row] * (1.f / 1024.f) + K_EPS);
                    f32x4 v[2][2]; float s = 0.f;
#pragma unroll
                    for (int bj = 0; bj < 2; ++bj)
#pragma unroll
                        for (int n = 0; n < 2; ++n) { v[bj][n] = acc[ai][bj][m][n] * rs2; s += sumsq4(v[bj][n]); }
                    s += __shfl_xor(s, 16); s += __shfl_xor(s, 32);
                    const float rh = rsqrtf(s * (1.f / 64.f) + K_EPS);
#pragma unroll
                    for (int bj = 0; bj < 2; ++bj) st16(dst + (size_t)row * 512 + cb + 32 * bj, pack8(v[bj][0] * rh * gv[bj][0], v[bj][1] * rh * gv[bj][1])); }
        } else {
            const int grp = (pn - 4) >> 1; bf16_t* dst = QB + (size_t)(pn >> 1) * (8u << 20); const int cb = ((pn - 4) & 1) * 256 + wc * 32 + 8 * fq;
#pragma unroll
            for (int ai = 0; ai < 2; ++ai) if (ai < nai)
#pragma unroll
                for (int m = 0; m < 4; ++m) { const int row = u.pm * BM + hoff + rowl + ai * HALF + m * 16; const float rs2 = rsqrtf(ss2[row] * (1.f / 1024.f) + K_EPS); float sq = 0.f;
#pragma unroll
                    for (int bj = 0; bj < 2; ++bj) { f32x4 v0 = acc[ai][bj][m][0] * rs2, v1 = acc[ai][bj][m][1] * rs2;
                        if (grp) {
#pragma unroll
                            for (int e = 0; e < 4; ++e) { v0[e] = gelu_tanh_f(v0[e]); v1[e] = gelu_tanh_f(v1[e]); } }
                        if (grp == 2) sq += sumsq4(v0) + sumsq4(v1);
                        st16(dst + (size_t)row * 512 + cb + bj * HALF, pack8(v0, v1)); }
                    if (grp == 2 && ssv) { sq += __shfl_xor(sq, 16); sq += __shfl_xor(sq, 32); if (fq == 0) atomicAdd(ssv + row, sq); } }
        }
    }
};

struct EpiCQ {
    static constexpr bool PERM = true, AFTER_DRAIN = true; static constexpr int MIDK = 0;
    const float* ss3; const float* g_cq; bf16_t* QC;
    __device__ __forceinline__ void midk(f32x4 (&)[2][2][4][2], const Unit&, int, int) const {}
    __device__ __forceinline__ void fused(f32x4 (&acc)[2][2][4][2], const Unit& u, int wr, int wc, int fr, int fq, PG8_LAS unsigned char* lds, int wid, int lane) const {
        PG8_LAS float* P = (PG8_LAS float*)lds;
#pragma unroll
        for (int ai = 0; ai < 2; ++ai)
#pragma unroll
            for (int m = 0; m < 4; ++m) { const int rowl = ai * HALF + wr * 64 + m * 16 + fr; const float r3 = rsqrtf(ss3[u.pm * BM + rowl] * (1.f / 1024.f) + K_EPS); float s = 0.f;
#pragma unroll
                for (int bj = 0; bj < 2; ++bj)
#pragma unroll
                    for (int n = 0; n < 2; ++n) { acc[ai][bj][m][n] *= r3; s += sumsq4(acc[ai][bj][m][n]); }
                s += __shfl_xor(s, 16); s += __shfl_xor(s, 32);
                if (fq == 0) P[rowl * 4 + wc] = s; }
        asm volatile("s_waitcnt lgkmcnt(0)" ::: "memory"); __builtin_amdgcn_s_barrier(); asm volatile("" ::: "memory");
        f32x4 gv[2][2];
#pragma unroll
        for (int bj = 0; bj < 2; ++bj)
#pragma unroll
            for (int n = 0; n < 2; ++n) gv[bj][n] = *(const f32x4*)(g_cq + bj * HALF + wc * 32 + 8 * fq + 4 * n) * K_C2C;
#pragma unroll
        for (int ai = 0; ai < 2; ++ai)
#pragma unroll
            for (int m = 0; m < 4; ++m) { const int rowl = ai * HALF + wr * 64 + m * 16 + fr; const f32x4 t = *(const PG8_LAS f32x4*)(P + rowl * 4);
                const float rh = rsqrtf(((t[0] + t[1]) + (t[2] + t[3])) * (1.f / 256.f) + K_EPS); bf16_t* rowp = QC + (size_t)(u.pm * BM + rowl) * 1024 + u.pn * BM + wc * 32 + 8 * fq;
#pragma unroll
                for (int bj = 0; bj < 2; ++bj) st16(rowp + bj * HALF, pack8(acc[ai][bj][m][0] * rh * gv[bj][0], acc[ai][bj][m][1] * rh * gv[bj][1])); }
    }
};
template <class Epi, class Sched, bool ALIGN_EPI = false, bool SP2 = false, bool HALFU = false>
__device__ __forceinline__ void gemm_phase(PG8_LAS unsigned char* lds, const Gemm g, const Sched& S, const Epi& E) {
    const int tid = threadIdx.x, wid = __builtin_amdgcn_readfirstlane(tid >> 6), lane = tid & 63, wr = wid >> 2, wc = wid & 3, fr = lane & 15, fq = lane >> 4;
    const int K = g.K, nt = K / BK;
    unsigned voffA[2], voffB[2];
#pragma unroll
    for (int i = 0; i < 2; ++i) { int R, C; stage_rc(tid * 16 + i * 8192, R, C); const int Rb = Epi::PERM ? ((R & ~31) + perm32(R & 31)) : R;
        voffA[i] = (unsigned)(R * K + C) * 2u; voffB[i] = (unsigned)(Rb * K + C) * 2u; }
    const size_t kstep = (size_t)(BK * 2);
    const size_t hstep = (size_t)HALF * K * 2;
    const size_t tstep = 2 * hstep;
    const unsigned ldsw = (unsigned)wid * 1024u;
    const int aoff = lds_byte(wr * 64 + fr, fq * 8), boff = lds_byte(wc * 32 + fr, fq * 8);
#define PG8_SA(b, h) (((b) * 2 + (h)) * HTB)
#define PG8_SB(b, h) ((4 + (b) * 2 + (h)) * HTB)
#define PG8_STAGE(bufoff, gbase, voff) do { _Pragma("unroll") for (int _i = 0; _i < 2; ++_i) \
        __builtin_amdgcn_global_load_lds((const unsigned*)((const char*)(gbase) + (voff)[_i]), (PG8_LAS unsigned*)(lds + (bufoff) + ldsw + _i * 8192), 16, 0, 0); } while (0)
#define PG8_LDA(dst, b, h) do { _Pragma("unroll") for (int m = 0; m < 4; ++m) _Pragma("unroll") for (int k = 0; k < 2; ++k) dst[m][k] = *(const PG8_LAS bf16x8*)(lds + PG8_SA(b, h) + aoff + m * 2048 + k * 1024); } while (0)
#define PG8_LDB(dst, b, h) do { _Pragma("unroll") for (int n = 0; n < 2; ++n) _Pragma("unroll") for (int k = 0; k < 2; ++k) dst[n][k] = *(const PG8_LAS bf16x8*)(lds + PG8_SB(b, h) + boff + n * 2048 + k * 1024); } while (0)
#define PG8_MMA(ai, bj, At, Bt) do { __builtin_amdgcn_s_setprio(1); _Pragma("unroll") for (int m = 0; m < 4; ++m) _Pragma("unroll") for (int n = 0; n < 2; ++n) _Pragma("unroll") for (int k = 0; k < 2; ++k) \
        acc[ai][bj][m][n] = __builtin_amdgcn_mfma_f32_16x16x32_bf16(Bt[n][k], At[m][k], acc[ai][bj][m][n], 0, 0, 0); __builtin_amdgcn_s_setprio(0); } while (0)
#define PG8_WAIT_V(n) asm volatile("s_waitcnt vmcnt(" #n ")" ::: "memory")
#define PG8_WAIT_L(n) asm volatile("s_waitcnt lgkmcnt(" #n ")" ::: "memory")
#define PG8_BAR __builtin_amdgcn_s_barrier()
#define PG8_SCHED __builtin_amdgcn_sched_barrier(0)
    Unit cur, nxt; int ui = 0;
    if (!S.next(0, cur)) return;
    f32x4 acc[2][2][4][2];
#pragma unroll
    for (int a = 0; a < 2; ++a)
#pragma unroll
        for (int b = 0; b < 2; ++b)
#pragma unroll
            for (int m = 0; m < 4; ++m)
#pragma unroll
                for (int n = 0; n < 2; ++n) acc[a][b][m][n] = (f32x4){0.f, 0.f, 0.f, 0.f};
    bf16x8 At[4][2], B0[2][2], B1[2][2];
    const char* cA = (const char*)g.A + (size_t)cur.pm * tstep + (unit_hm(cur) > 0 ? hstep : (size_t)0); const char* cB = (const char*)g.Bt + (size_t)unit_pn(cur) * tstep;
    bool full = unit_hm(cur) < 0;
    S.a_ready(cur);
    if constexpr (SP2) {
        PG8_STAGE(PG8_SB(0, 0), cB, voffB); PG8_STAGE(PG8_SB(0, 1), cB + hstep, voffB); PG8_STAGE(PG8_SA(0, 0), cA, voffA); PG8_STAGE(PG8_SA(0, 1), cA + hstep, voffA);
        if (wr == 1) PG8_BAR;
        PG8_WAIT_V(2); PG8_BAR;
        PG8_STAGE(PG8_SB(1, 0), cB + kstep, voffB); PG8_STAGE(PG8_SA(1, 0), cA + kstep, voffA); PG8_STAGE(PG8_SB(1, 1), cB + hstep + kstep, voffB);
        PG8_WAIT_V(6); PG8_BAR;
    } else {
        PG8_STAGE(PG8_SB(0, 0), cB, voffB); PG8_STAGE(PG8_SA(0, 0), cA, voffA); PG8_STAGE(PG8_SB(0, 1), cB + hstep, voffB); PG8_STAGE(PG8_SA(0, 1), cA + hstep, voffA);
        if (wr == 1) PG8_BAR;
        PG8_WAIT_V(4); PG8_BAR;
        PG8_STAGE(PG8_SB(1, 0), cB + kstep, voffB); PG8_STAGE(PG8_SA(1, 0), cA + kstep, voffA); PG8_STAGE(PG8_SB(1, 1), cB + hstep + kstep, voffB);
        PG8_WAIT_V(6); PG8_BAR;
    }
    for (;;) {
        const bool has_next = S.next(ui + 1, nxt);
        const char* nA = has_next ? (const char*)g.A + (size_t)nxt.pm * tstep + (unit_hm(nxt) > 0 ? hstep : (size_t)0) : cA; const char* nB = has_next ? (const char*)g.Bt + (size_t)unit_pn(nxt) * tstep : cB;
        for (int t = 0; t < nt; t += 2) {
            if constexpr (Epi::MIDK > 0) { if (t == Epi::MIDK) E.midk(acc, cur, wr, fr); }
            const bool last = (t == nt - 2);
            const char* a1 = cA + (size_t)(t + 1) * kstep;
            const char* a2 = last ? nA : cA + (size_t)(t + 2) * kstep; const char* b2 = last ? nB : cB + (size_t)(t + 2) * kstep;
            const char* a3 = a2 + kstep; const char* b3 = b2 + kstep;
            if (last && has_next) S.a_ready(nxt);
            if constexpr (SP2) {
            PG8_LDB(B0, 0, 0); PG8_LDB(B1, 0, 1); PG8_SCHED; PG8_LDA(At, 0, 0); PG8_STAGE(PG8_SA(1, 1), a1 + hstep, voffA);
            PG8_WAIT_V(8); PG8_WAIT_L(0); PG8_BAR; PG8_MMA(0, 0, At, B0); PG8_MMA(0, 1, At, B1); PG8_BAR; PG8_SCHED;
            PG8_LDA(At, 0, 1); PG8_STAGE(PG8_SB(0, 0), b2, voffB); PG8_STAGE(PG8_SB(0, 1), b2 + hstep, voffB); PG8_STAGE(PG8_SA(0, 0), a2, voffA);
            PG8_WAIT_V(8); PG8_WAIT_L(0); PG8_BAR; if (!HALFU || full) { PG8_MMA(1, 0, At, B0); PG8_MMA(1, 1, At, B1); } PG8_BAR; PG8_SCHED;
            PG8_LDB(B0, 1, 0); PG8_LDB(B1, 1, 1); PG8_SCHED; PG8_LDA(At, 1, 0); PG8_STAGE(PG8_SA(0, 1), a2 + hstep, voffA);
            PG8_WAIT_V(8); PG8_WAIT_L(0); PG8_BAR; PG8_MMA(0, 0, At, B0); PG8_MMA(0, 1, At, B1); PG8_BAR; PG8_SCHED;
            PG8_LDA(At, 1, 1); PG8_STAGE(PG8_SB(1, 0), b3, voffB); PG8_STAGE(PG8_SB(1, 1), b3 + hstep, voffB); PG8_STAGE(PG8_SA(1, 0), a3, voffA);
            PG8_WAIT_V(8); PG8_WAIT_L(0); PG8_BAR; if (!HALFU || full) { PG8_MMA(1, 0, At, B0); PG8_MMA(1, 1, At, B1); } PG8_BAR; PG8_SCHED;
            } else {
            PG8_LDB(B0, 0, 0); PG8_SCHED; PG8_LDA(At, 0, 0); PG8_STAGE(PG8_SA(1, 1), a1 + hstep, voffA);
            PG8_WAIT_L(8); PG8_BAR; PG8_WAIT_L(0); PG8_MMA(0, 0, At, B0); PG8_BAR; PG8_SCHED;
            PG8_LDB(B1, 0, 1); PG8_STAGE(PG8_SB(0, 0), b2, voffB);
            PG8_BAR; PG8_WAIT_L(0); PG8_MMA(0, 1, At, B1); PG8_BAR;
            PG8_LDA(At, 0, 1); PG8_STAGE(PG8_SA(0, 0), a2, voffA);
            PG8_BAR; PG8_WAIT_L(0); PG8_MMA(1, 0, At, B0); PG8_BAR; PG8_SCHED;
            PG8_STAGE(PG8_SB(0, 1), b2 + hstep, voffB);
            PG8_WAIT_V(6); PG8_BAR; PG8_MMA(1, 1, At, B1); PG8_BAR;
            PG8_LDB(B0, 1, 0); PG8_SCHED; PG8_LDA(At, 1, 0); PG8_STAGE(PG8_SA(0, 1), a2 + hstep, voffA);
            PG8_WAIT_L(8); PG8_BAR; PG8_WAIT_L(0); PG8_MMA(0, 0, At, B0); PG8_BAR; PG8_SCHED;
            PG8_LDB(B1, 1, 1); PG8_STAGE(PG8_SB(1, 0), b3, voffB);
            PG8_BAR; PG8_WAIT_L(0); PG8_MMA(0, 1, At, B1); PG8_BAR;
            PG8_LDA(At, 1, 1); PG8_STAGE(PG8_SA(1, 0), a3, voffA);
            PG8_BAR; PG8_WAIT_L(0); PG8_MMA(1, 0, At, B0); PG8_BAR; PG8_SCHED;
            PG8_STAGE(PG8_SB(1, 1), b3 + hstep, voffB);
            PG8_WAIT_V(6); PG8_BAR; PG8_MMA(1, 1, At, B1); PG8_BAR;
            }
        }
        if constexpr (ALIGN_EPI) { if (wr == 0) PG8_BAR; }
        if constexpr (!Epi::AFTER_DRAIN) { E(acc, cur, wr, wc, fr, fq); S.done(cur); }
        if (!has_next) break;
#pragma unroll
        for (int a = 0; a < 2; ++a)
#pragma unroll
            for (int b = 0; b < 2; ++b)
#pragma unroll
                for (int m = 0; m < 4; ++m)
#pragma unroll
                    for (int n = 0; n < 2; ++n) acc[a][b][m][n] = (f32x4){0.f, 0.f, 0.f, 0.f};
        cur = nxt; cA = nA; cB = nB; ++ui; full = unit_hm(cur) < 0;
        if constexpr (ALIGN_EPI) { if (wr == 1) PG8_BAR; }
    }
    PG8_WAIT_V(0);
    if constexpr (!ALIGN_EPI) { if (wr == 0) PG8_BAR; }
    PG8_BAR;
    if constexpr (Epi::AFTER_DRAIN) { E.fused(acc, cur, wr, wc, fr, fq, lds, wid, lane); S.done(cur); }
#undef PG8_SA
#undef PG8_SB
#undef PG8_STAGE
#undef PG8_LDA
#undef PG8_LDB
#undef PG8_MMA
#undef PG8_WAIT_V
#undef PG8_WAIT_L
#undef PG8_BAR
#undef PG8_SCHED
}
}
#ifndef PG8_SP2
#define PG8_SP2 true
#endif
#ifndef PG8_ALIGN
#define PG8_ALIGN true
#endif
namespace attn_body {
using bf16=__hip_bfloat16;
using bf16x8=__attribute__((ext_vector_type(8)))short;
using s16x4=__attribute__((ext_vector_type(4)))short;
using f32x16=__attribute__((ext_vector_type(16)))float;
using u32x4=__attribute__((ext_vector_type(4)))unsigned;
constexpr int BATCH=4,NHEAD=8,SEQ=4096,D=64,DM=NHEAD*D;
constexpr int NW=8,QBLK=32,QB=QBLK*NW,KVBLK=64,NQB=SEQ/QB;
constexpr int ATTN_PITCH=DM, ATTN_UNIT_ROWS=QB;
__device__ __forceinline__ int crow(int r,int hi){return (r&3)+8*(r>>2)+4*hi;}
#define SBAR() __builtin_amdgcn_sched_barrier(0)
__device__ __forceinline__ void cmask(f32x16&p0,f32x16&p1,int jb,int qrel,int hi){
  const float NEG=-INFINITY; int kb=64*jb+4*hi;
  #pragma unroll
  for(int r=0;r<16;++r){int kv=kb+(r&3)+8*(r>>2); if(kv>qrel)p0[r]=NEG; if(kv+32>qrel)p1[r]=NEG;}
}

constexpr int NSLOT=3, SLOTB=8192;
constexpr int LDS_K=0, LDS_V=NSLOT*SLOTB, LDS_WS=2*NSLOT*SLOTB, LDS_OST=LDS_WS+NW*64*4, LDS_C=LDS_OST+NW*4096, LDS_SCAN=LDS_C+SEQ*4, LDS_BYTES=LDS_SCAN+64;
constexpr float C2=0.125f*1.4426950408889634f;
__device__ __forceinline__ void glds16(const void*gsrc,unsigned lds_dst){unsigned keep;
  asm volatile("s_mov_b32 %0, m0\n\ts_mov_b32 m0, %2\n\ts_nop 0\n\tglobal_load_lds_dwordx4 %1, off\n\ts_mov_b32 m0, %0":"=&s"(keep):"v"(gsrc),"s"(lds_dst):"memory");}
__device__ __forceinline__ float max3f(float a,float b,float c){float r;asm("v_max3_f32 %0, %1, %2, %3":"=v"(r):"v"(a),"v"(b),"v"(c));return r;}
__device__ __forceinline__ float max2f(float a,float b){float r;asm("v_max_f32_e32 %0, %1, %2":"=v"(r):"v"(a),"v"(b));return r;}
__device__ __forceinline__ float fadd_s(float a,float b){float r;asm("v_add_f32_e32 %0, %1, %2":"=v"(r):"v"(a),"v"(b));return r;}
__device__ __forceinline__ float fsub_s(float a,float b){float r;asm("v_sub_f32_e32 %0, %1, %2":"=v"(r):"v"(a),"v"(b));return r;}
typedef float f32x2_t __attribute__((ext_vector_type(2))); typedef __bf16 bf16x2_t __attribute__((ext_vector_type(2)));
__device__ __forceinline__ unsigned cvtpk_s(float lo,float hi){f32x2_t v={lo,hi};bf16x2_t b=__builtin_convertvector(v,bf16x2_t);return __builtin_bit_cast(unsigned,b);}
#define WAIT_BAR(N) asm volatile("s_waitcnt vmcnt(" #N ") lgkmcnt(0)\n\ts_barrier":::"memory")

__device__ __forceinline__ void qkt(f32x16&p0,f32x16&p1,const char*Kslot,const bf16x8*qr,int r32,int hi){
  const char*kb=Kslot+hi*1024+r32*16;
  #pragma unroll
  for(int d0=0;d0<4;++d0){
    const bf16x8 b0=*reinterpret_cast<const bf16x8*>(kb+d0*2048);
    const bf16x8 b1=*reinterpret_cast<const bf16x8*>(kb+d0*2048+512);
    p0=__builtin_amdgcn_mfma_f32_32x32x16_bf16(b0,qr[d0],p0,0,0,0);p1=__builtin_amdgcn_mfma_f32_32x32x16_bf16(b1,qr[d0],p1,0,0,0);}
}
typedef __attribute__((address_space(3))) const char* lds_cptr;
typedef short v4i16_t __attribute__((ext_vector_type(4)));
__device__ __forceinline__ void kload8(bf16x8*kf,lds_cptr kp){
  kf[0]=*(const __attribute__((address_space(3))) bf16x8*)(kp);      kf[1]=*(const __attribute__((address_space(3))) bf16x8*)(kp+512);
  kf[2]=*(const __attribute__((address_space(3))) bf16x8*)(kp+2048); kf[3]=*(const __attribute__((address_space(3))) bf16x8*)(kp+2560);
  kf[4]=*(const __attribute__((address_space(3))) bf16x8*)(kp+4096); kf[5]=*(const __attribute__((address_space(3))) bf16x8*)(kp+4608);
  kf[6]=*(const __attribute__((address_space(3))) bf16x8*)(kp+6144); kf[7]=*(const __attribute__((address_space(3))) bf16x8*)(kp+6656);
}
__device__ __forceinline__ void kload2(bf16x8*kf,lds_cptr kp,int j){ kf[2*j]=*(const __attribute__((address_space(3))) bf16x8*)(kp+j*2048); kf[2*j+1]=*(const __attribute__((address_space(3))) bf16x8*)(kp+j*2048+512); }
__device__ __forceinline__ s16x4 vtr(lds_cptr p){ return __builtin_bit_cast(s16x4,__builtin_amdgcn_ds_read_tr16_b64_v4i16((__attribute__((address_space(3))) v4i16_t*)p)); }
__device__ __forceinline__ float rowmax(const f32x16&p0,const f32x16&p1){
  float a=max3f(p0[0],p0[1],p1[0]),b=max3f(p0[2],p0[3],p1[1]);a=max3f(a,p1[2],p1[3]);
  #pragma unroll
  for(int r=4;r<16;r+=4){a=max3f(a,p0[r],p0[r+1]);b=max3f(b,p0[r+2],p0[r+3]);a=max3f(a,p1[r],p1[r+1]);b=max3f(b,p1[r+2],p1[r+3]);}
  const float m=max2f(a,b);
  auto rr=__builtin_amdgcn_permlane32_swap(__float_as_uint(m),__float_as_uint(m),false,false);
  return max2f(__uint_as_float(rr[0]),__uint_as_float(rr[1]));
}
__device__ __forceinline__ void pv(f32x16*o,int vb,bf16x8 pa0,bf16x8 pa1,bf16x8 pa2,bf16x8 pa3){
  #pragma unroll
  for(int d0=0;d0<2;++d0){s16x4 lo[4],hi[4];
    #pragma unroll
    for(int ks=0;ks<4;++ks){
      asm volatile("ds_read_b64_tr_b16 %0,%1 offset:%c2":"=&v"(lo[ks]):"v"(vb),"i"(d0*4096+ks*1024):"memory");
      asm volatile("ds_read_b64_tr_b16 %0,%1 offset:%c2":"=&v"(hi[ks]):"v"(vb),"i"(d0*4096+ks*1024+512):"memory");}
    asm volatile("s_waitcnt lgkmcnt(0)":::"memory");SBAR();
    #define PK(k) (bf16x8){lo[k][0],lo[k][1],lo[k][2],lo[k][3],hi[k][0],hi[k][1],hi[k][2],hi[k][3]}
    o[d0]=__builtin_amdgcn_mfma_f32_32x32x16_bf16(pa0,PK(0),o[d0],0,0,0);
    o[d0]=__builtin_amdgcn_mfma_f32_32x32x16_bf16(pa1,PK(1),o[d0],0,0,0);
    o[d0]=__builtin_amdgcn_mfma_f32_32x32x16_bf16(pa2,PK(2),o[d0],0,0,0);
    o[d0]=__builtin_amdgcn_mfma_f32_32x32x16_bf16(pa3,PK(3),o[d0],0,0,0);
    #undef PK
  }
}

#ifndef ATTN_STORE16
#define ATTN_STORE16(p,v) (*(u32x4*)(p)=(v))
#endif
template<int THRL> __device__ __forceinline__ void attn_unit(int b,int h,int qb,const bf16*Q,const bf16*__restrict__ K,const bf16*__restrict__ V,unsigned short*Y,const float*gfo,float*ssa,char*shm,int t0){
  int tid=threadIdx.x; asm volatile("":"+v"(tid)); const int lane=tid&63,r32=lane&31,hi=lane>>5; const int wid=__builtin_amdgcn_readfirstlane(tid>>6);
  const long rowbase=(long)b*SEQ; const int q0=qb*QB;
  const bf16*Qw=Q+(rowbase+q0+wid*QBLK)*DM+h*D;
  const bf16*Kh=K+(rowbase+(long)t0*KVBLK)*DM+h*D,*Vh=V+(rowbase+(long)t0*KVBLK)*DM+h*D;
  const unsigned lds0=(unsigned)(uintptr_t)shm;
  float*wsf=(float*)(shm+LDS_WS)+wid*64;
  const bf16*ksrc=Kh+(long)lane*DM+wid*8;
  const bf16*vsrc=Vh+(long)(16*(wid&3)+(lane>>2))*DM+(wid>>2)*32+(lane&3)*8;
  const unsigned kdst=lds0+LDS_K+wid*1024, vdst=lds0+LDS_V+wid*1024;
  #define DMA_K(t,slot) glds16(ksrc+(long)(t)*KVBLK*DM,(unsigned)__builtin_amdgcn_readfirstlane(kdst+(slot)))
  #define DMA_V(t,slot) glds16(vsrc+(long)(t)*KVBLK*DM,(unsigned)__builtin_amdgcn_readfirstlane(vdst+(slot)))
  const int vb0=(int)(lds0+LDS_V)+((lane>>4)&1)*32+(lane&3)*8+(4*hi+((lane&15)>>2))*64;
  const char*Kbase=shm+LDS_K; bf16x8 kf[8];
  const lds_cptr shm3=(lds_cptr)shm; const lds_cptr kp0=shm3+LDS_K+hi*1024+r32*16; const lds_cptr vp0=shm3+LDS_V+((lane>>4)&1)*32+(lane&3)*8+(4*hi+((lane&15)>>2))*64;
  const int NT=(q0+QB)/KVBLK-t0;
  DMA_K(0,0);DMA_V(0,0);DMA_K(1,SLOTB);
  bf16x8 qr[4];
  #pragma unroll
  for(int d0=0;d0<4;++d0)qr[d0]=*reinterpret_cast<const bf16x8*>(&Qw[(long)r32*DM+d0*16+hi*8]);
  float mhat=0.f,l_reg=0.f;f32x16 o[2];o[0]=f32x16{};o[1]=f32x16{};
  typedef float f32x4_t __attribute__((ext_vector_type(4)));
  const lds_cptr clb=(lds_cptr)shm+LDS_C+t0*256;
  mhat=-((const __attribute__((address_space(3))) float*)((lds_cptr)shm+LDS_C))[q0+wid*QBLK+r32];
  #define BIAS(C0,C1,t) do{ const float bs_=-mhat; const int hl_=(int)(__builtin_amdgcn_mbcnt_hi(~0u,__builtin_amdgcn_mbcnt_lo(~0u,0u))>>5); const __attribute__((address_space(3))) f32x4_t* cl4=(const __attribute__((address_space(3))) f32x4_t*)(clb+(t)*256)+hl_; \
      _Pragma("unroll") for(int j_=0;j_<4;++j_){ const f32x4_t a_=cl4[2*j_], b_=cl4[8+2*j_]; \
      _Pragma("unroll") for(int e_=0;e_<4;++e_){ C0[4*j_+e_]=bs_-a_[e_]; C1[4*j_+e_]=bs_-b_[e_]; } } }while(0)
  const int qrel=wid*QBLK+r32;
  #define CMASK(P0,P1,t) do{int jb_=(t)-(NT-4); if(jb_>=0)cmask(P0,P1,jb_,qrel,hi);}while(0)
  #define START(P0,P1) do{ _Pragma("unroll") for(int r=0;r<16;++r)P0[r]=__builtin_amdgcn_exp2f(P0[r]); }while(0)
  #define RESC() do{}while(0)
  f32x16 pA0,pA1,pB0,pB1;
  int sl_prev=0,sl_cur=0,sl_next=SLOTB;
  #define ROT() do{sl_prev=sl_cur;sl_cur=sl_next;sl_next=(sl_next==(NSLOT-1)*SLOTB)?0:sl_next+SLOTB;}while(0)
  DMA_K(2,2*SLOTB);
  WAIT_BAR(3);
  BIAS(pA0,pA1,0); qkt(pA0,pA1,Kbase,qr,r32,hi);asm volatile("s_nop 15\n\ts_nop 7":"+v"(pA0),"+v"(pA1));CMASK(pA0,pA1,0);
  START(pA0,pA1);
  _Pragma("unroll") for(int r=0;r<16;++r)pA1[r]=__builtin_amdgcn_exp2f(pA1[r]);
  WAIT_BAR(0);
  DMA_K(3,0);DMA_V(1,SLOTB);
  ROT();
  kload8(kf,kp0+sl_cur);
  WAIT_BAR(2);
  s16x4 vlo[8],vhi[8]; u32x4 pw0,pw1,pw2,pw3;
  #define PKW(P,B) cvtpk_s(P[B],P[B+1])
  #define PAF(k) __builtin_bit_cast(bf16x8,pw##k)
  #define VFR(i) (bf16x8){vlo[i][0],vlo[i][1],vlo[i][2],vlo[i][3],vhi[i][0],vhi[i][1],vhi[i][2],vhi[i][3]}
  #define PIN(x) asm volatile("":"+v"(x))
  #define MX3(a,b,c) __builtin_fmaxf(__builtin_fmaxf((a),(b)),(c))
  #define GAPA(MF,A0,A1,A2,A3,W0,W1,PW) do{ MF; sacc+=A0; sacc+=A1; sacc+=A2; sacc+=A3; PIN(sacc); W0; W1; PIN(PW); SBAR(); }while(0)
  #define EX(v) __builtin_amdgcn_exp2f(v)
  #define GAPB(MF,X,B) do{ MF; X[B]=EX(X[B]); X[B+1]=EX(X[B+1]); X[B+2]=EX(X[B+2]); X[B+3]=EX(X[B+3]); PIN(X); SBAR(); }while(0)
  #define VRD(i) do{ vlo[i]=vtr(vp_+(((i)>>2)*4096+((i)&3)*1024)); vhi[i]=vtr(vp_+(((i)>>2)*4096+((i)&3)*1024+512)); }while(0)
  #define KRD(G,j) do{ if(G){ kload2(kf,kp0+sl_next,j); SBAR(); } }while(0)
  #define STEP(C0,C1,P0,P1,t,GK,GV,GL) do{ BIAS(C0,C1,t); SBAR(); \
    const lds_cptr vp_=vp0+sl_prev; \
    VRD(0); SBAR(); float sacc=(P0[0]+P0[1]); \
    GAPA(C0=__builtin_amdgcn_mfma_f32_32x32x16_bf16(kf[0],qr[0],C0,0,0,0), P0[2],P0[3],P0[4],P0[5],     pw0[0]=PKW(P0,0), pw0[1]=PKW(P0,2), pw0); \
    VRD(4); SBAR(); GAPA(C1=__builtin_amdgcn_mfma_f32_32x32x16_bf16(kf[1],qr[0],C1,0,0,0), P0[6],P0[7],P0[8],P0[9],     pw0[2]=PKW(P0,4), pw0[3]=PKW(P0,6), pw0); \
    VRD(1); SBAR(); GAPA(C0=__builtin_amdgcn_mfma_f32_32x32x16_bf16(kf[2],qr[1],C0,0,0,0),   P0[10],P0[11],P0[12],P0[13], pw1[0]=PKW(P0,8), pw1[1]=PKW(P0,10), pw1); \
    VRD(5); SBAR(); GAPA(C1=__builtin_amdgcn_mfma_f32_32x32x16_bf16(kf[3],qr[1],C1,0,0,0),   P0[14],P0[15],P1[0],P1[1],   pw1[2]=PKW(P0,12),pw1[3]=PKW(P0,14), pw1); \
    VRD(2); SBAR(); GAPA(C0=__builtin_amdgcn_mfma_f32_32x32x16_bf16(kf[4],qr[2],C0,0,0,0),   P1[2],P1[3],P1[4],P1[5],     pw2[0]=PKW(P1,0), pw2[1]=PKW(P1,2), pw2); \
    VRD(6); SBAR(); GAPA(C1=__builtin_amdgcn_mfma_f32_32x32x16_bf16(kf[5],qr[2],C1,0,0,0),   P1[6],P1[7],P1[8],P1[9],     pw2[2]=PKW(P1,4), pw2[3]=PKW(P1,6), pw2); \
    VRD(3); SBAR(); GAPA(C0=__builtin_amdgcn_mfma_f32_32x32x16_bf16(kf[6],qr[3],C0,0,0,0),   P1[10],P1[11],P1[12],P1[13], pw3[0]=PKW(P1,8), pw3[1]=PKW(P1,10), pw3); \
    VRD(7); SBAR(); GAPA(C1=__builtin_amdgcn_mfma_f32_32x32x16_bf16(kf[7],qr[3],C1,0,0,0),   P1[14],P1[15],0.f,0.f,       pw3[2]=PKW(P1,12),pw3[3]=PKW(P1,14), pw3); \
    l_reg+=sacc; \
    if(GK){DMA_K((t)+3,sl_cur);} if(GV){DMA_V((t)+1,sl_next);} \
    CMASK(C0,C1,t); \
    SBAR(); \
    GAPB(o[0]=__builtin_amdgcn_mfma_f32_32x32x16_bf16(PAF(0),VFR(0),o[0],0,0,0), C0,0); \
    GAPB(o[1]=__builtin_amdgcn_mfma_f32_32x32x16_bf16(PAF(0),VFR(4),o[1],0,0,0), C0,4); \
    KRD(GL,0); GAPB(o[0]=__builtin_amdgcn_mfma_f32_32x32x16_bf16(PAF(1),VFR(1),o[0],0,0,0), C0,8); \
    KRD(GL,1); GAPB(o[1]=__builtin_amdgcn_mfma_f32_32x32x16_bf16(PAF(1),VFR(5),o[1],0,0,0), C0,12); \
    KRD(GL,2); GAPB(o[0]=__builtin_amdgcn_mfma_f32_32x32x16_bf16(PAF(2),VFR(2),o[0],0,0,0), C1,0); \
    KRD(GL,3); GAPB(o[1]=__builtin_amdgcn_mfma_f32_32x32x16_bf16(PAF(2),VFR(6),o[1],0,0,0), C1,4); \
    GAPB(o[0]=__builtin_amdgcn_mfma_f32_32x32x16_bf16(PAF(3),VFR(3),o[0],0,0,0), C1,8); \
    GAPB(o[1]=__builtin_amdgcn_mfma_f32_32x32x16_bf16(PAF(3),VFR(7),o[1],0,0,0), C1,12); \
    }while(0)
  int t=1;
  #undef CMASK
  #define CMASK(P0,P1,t) do{}while(0)
  for(;t+5<NT;t+=2){
    STEP(pB0,pB1,pA0,pA1,t,true,true,true);     WAIT_BAR(2); RESC(); ROT();
    STEP(pA0,pA1,pB0,pB1,t+1,true,true,true);   WAIT_BAR(2); RESC(); ROT();
  }
  #undef CMASK
  #define CMASK(P0,P1,t) do{int jb_=(t)-(NT-4); if(jb_>=0)cmask(P0,P1,jb_,qrel,hi);}while(0)
  #define ENDW(tt) do{ if((tt)+3<NT){WAIT_BAR(2);} else if((tt)+2<NT){WAIT_BAR(1);} else {WAIT_BAR(0);} }while(0)
  for(;t+1<NT;t+=2){
    STEP(pB0,pB1,pA0,pA1,t,(t+3<NT),(t+1<NT),(t+1<NT));       ENDW(t);   RESC(); ROT();
    STEP(pA0,pA1,pB0,pB1,t+1,(t+4<NT),(t+2<NT),(t+2<NT));     ENDW(t+1); RESC(); ROT();
  }
  STEP(pB0,pB1,pA0,pA1,NT-1,false,false,false); RESC();
  { float sacc=pB0[0]+pB0[1]; _Pragma("unroll") for(int r=2;r<16;++r)sacc+=pB0[r]; _Pragma("unroll") for(int r=0;r<16;++r)sacc+=pB1[r]; l_reg+=sacc;
    pw0=(u32x4){PKW(pB0,0),PKW(pB0,2),PKW(pB0,4),PKW(pB0,6)};pw1=(u32x4){PKW(pB0,8),PKW(pB0,10),PKW(pB0,12),PKW(pB0,14)};pw2=(u32x4){PKW(pB1,0),PKW(pB1,2),PKW(pB1,4),PKW(pB1,6)};pw3=(u32x4){PKW(pB1,8),PKW(pB1,10),PKW(pB1,12),PKW(pB1,14)};
    SBAR(); pv(o,vb0+sl_cur,PAF(0),PAF(1),PAF(2),PAF(3)); }
  #undef PKW
  #undef PAF
  #undef VFR
  #undef PIN
  #undef MX3
  #undef GAPA
  #undef GAPB
  #undef EX
  #undef VRD
  #undef KRD
  #undef STEP
  #undef ENDW
  {auto rr=__builtin_amdgcn_permlane32_swap(__float_as_uint(l_reg),__float_as_uint(l_reg),false,false);l_reg=__uint_as_float(rr[0])+__uint_as_float(rr[1]);}
  if(hi==0)wsf[32+r32]=l_reg;asm volatile("s_waitcnt lgkmcnt(0)":::"memory");
  float rli[16];
  #pragma unroll
  for(int r=0;r<16;++r)rli[r]=__builtin_amdgcn_rcpf(wsf[32+crow(r,hi)]);
  unsigned short*Ow=Y+(rowbase+q0+wid*QBLK)*1024+h*D; float*ssw=ssa+(rowbase+q0+wid*QBLK);
  { bf16*stg=(bf16*)(shm+LDS_OST)+wid*2048;
    #pragma unroll
    for(int r=0;r<16;++r){const int orow=crow(r,hi);
      #pragma unroll
      for(int d0=0;d0<2;++d0)stg[orow*64+d0*32+r32]=__float2bfloat16(o[d0][r]*rli[r]);}
    asm volatile("s_waitcnt lgkmcnt(0)":::"memory");
    #pragma unroll
    for(int i=0;i<4;++i){const int row=i*8+(lane>>3),ch=lane&7; const u32x4 v=*(const u32x4*)(stg+row*64+ch*8);
      const f32x4_t g0=*(const f32x4_t*)(gfo+h*D+ch*8), g1=*(const f32x4_t*)(gfo+h*D+ch*8+4); float sq=0.f; u32x4 w;
      { const float a0=__uint_as_float(v[0]<<16),a1=__uint_as_float(v[0]&0xffff0000u),a2=__uint_as_float(v[1]<<16),a3=__uint_as_float(v[1]&0xffff0000u); sq+=(a0*a0+a1*a1)+(a2*a2+a3*a3); w[0]=cvtpk_s(a0*g0[0],a1*g0[1]); w[1]=cvtpk_s(a2*g0[2],a3*g0[3]); }
      { const float a0=__uint_as_float(v[2]<<16),a1=__uint_as_float(v[2]&0xffff0000u),a2=__uint_as_float(v[3]<<16),a3=__uint_as_float(v[3]&0xffff0000u); sq+=(a0*a0+a1*a1)+(a2*a2+a3*a3); w[2]=cvtpk_s(a0*g1[0],a1*g1[1]); w[3]=cvtpk_s(a2*g1[2],a3*g1[3]); }
      sq+=__shfl_xor(sq,1); sq+=__shfl_xor(sq,2); sq+=__shfl_xor(sq,4); if(ch==0&&ssa)atomicAdd(ssw+row,sq);
      *(u32x4*)(Ow+(long)row*1024+ch*8)=w;} }
  asm volatile("s_waitcnt lgkmcnt(0)\n\ts_barrier":::"memory");
  #undef DMA_K
  #undef DMA_V
  #undef CMASK
  #undef START
  #undef RESC
  #undef ROT
  #undef BIAS
}
constexpr int ATTN_LDS_BYTES=LDS_BYTES;
struct AttnTensors { const bf16* Q; const bf16* K; const bf16* V; unsigned short* Y; const float* gfo; float* ssa; const float* logf; const float* gq; const float* gk; unsigned* queue; };
struct AttnUnit { int bh; int qb; };
struct StaticOrder {
  int vcu;
  __device__ __forceinline__ explicit StaticOrder(int grid,int block):vcu((block%8)*(grid/8)+block/8){}
  __device__ __forceinline__ bool next(int i,AttnUnit&u)const{ if(i>=2)return false; const int s=vcu&7; u.bh=vcu>>3; u.qb=(i==0)?s:15-s; return true; }
  __device__ __forceinline__ void a_ready(const AttnUnit&)const{}
  __device__ __forceinline__ void done(const AttnUnit&)const{}
};
template<class Sched,int THRL=40> __device__ __forceinline__ void attn_phase(char*lds,const AttnTensors&T,const Sched&){
  typedef float f32x4_t __attribute__((ext_vector_type(4)));
  float*scan=(float*)(lds+LDS_SCAN);
  float B2;
  { const int lane=threadIdx.x&63; float a=fabsf(T.gq[lane]),b=fabsf(T.gk[lane]);
    _Pragma("unroll") for(int o=1;o<64;o<<=1){ a=fmaxf(a,__shfl_xor(a,o)); b=fmaxf(b,__shfl_xor(b,o)); }
    B2=2.f*(64.f*C2*1.02f)*a*b; B2=__builtin_bit_cast(float,__builtin_amdgcn_readfirstlane(__builtin_bit_cast(int,B2))); }
  int cur_bh=-1;
  for(;;){
    int tid=threadIdx.x; asm volatile("":"+v"(tid)); const int lane=tid&63,wid=tid>>6;
    if(tid==0){ const unsigned n=__hip_atomic_fetch_add(T.queue,1u,__ATOMIC_RELAXED,__HIP_MEMORY_SCOPE_AGENT); ((unsigned*)scan)[8]=n; }
    asm volatile("s_waitcnt vmcnt(0) lgkmcnt(0)\n\ts_barrier":::"memory");
    const unsigned n=(unsigned)__builtin_amdgcn_readfirstlane((int)((volatile unsigned*)scan)[8]);
    if(n>=512u)break;
    const int qb=15-(int)(n>>5),bh=(int)(n&31u);
    if(bh!=cur_bh){ cur_bh=bh;
      const f32x4_t*src=(const f32x4_t*)(T.logf+(long)bh*SEQ)+2*tid; const f32x4_t a=src[0],b=src[1];
      f32x4_t v0=a,v1=b; v0[1]+=v0[0]; v0[2]+=v0[1]; v0[3]+=v0[2]; v1[0]+=v0[3]; v1[1]+=v1[0]; v1[2]+=v1[1]; v1[3]+=v1[2];
      float inc=v1[3];
      _Pragma("unroll") for(int o=1;o<64;o<<=1){ const float t=__shfl_up(inc,o); if(lane>=o)inc+=t; }
      if(lane==63)scan[wid]=inc;
      asm volatile("s_waitcnt lgkmcnt(0)\n\ts_barrier":::"memory");
      float base=inc-v1[3]; for(int w=0;w<wid;++w)base+=scan[w];
      f32x4_t*cl=(f32x4_t*)(lds+LDS_C)+2*tid;
      cl[0]=(v0+base)*1.4426950408889634f; cl[1]=(v1+base)*1.4426950408889634f;
      asm volatile("s_waitcnt lgkmcnt(0)\n\ts_barrier":::"memory");
    }
    { const float*cl=(const float*)(lds+LDS_C); const int ntf=4*qb+4;
      if(wid==0){ const float thr=cl[qb*QB]+150.f+B2; const bool sk=(lane<ntf-4)&&(cl[64*lane+63]>thr);
        const int cnt=__popcll(__ballot(sk)); if(lane==0)((int*)scan)[9]=cnt&~1; }
      asm volatile("s_waitcnt lgkmcnt(0)\n\ts_barrier":::"memory");
    }
    const int t0=__builtin_amdgcn_readfirstlane(((volatile int*)scan)[9]);
    attn_unit<THRL>(bh/NHEAD,bh%NHEAD,qb,T.Q,T.K,T.V,T.Y,T.gfo,T.ssa,lds,t0);
  }
}
#undef SBAR
#undef WAIT_BAR
}
#define GAS __attribute__((address_space(1)))
#define LAS __attribute__((address_space(3)))
typedef unsigned short bf16;
typedef unsigned v4u __attribute__((ext_vector_type(4)));
typedef float f32x4 __attribute__((ext_vector_type(4)));
typedef short bf16x8 __attribute__((ext_vector_type(8)));
typedef GAS unsigned gu32;
typedef GAS unsigned long long gu64;
#define RLX_AGENT __ATOMIC_RELAXED, __HIP_MEMORY_SCOPE_AGENT
#define LDS_WAIT() asm volatile("s_waitcnt lgkmcnt(0)" ::: "memory")
#define VM_WAIT() asm volatile("s_waitcnt vmcnt(0)" ::: "memory")
__device__ __forceinline__ unsigned long long rt() { return __builtin_amdgcn_s_memrealtime(); }
__device__ __forceinline__ unsigned f2bf(float f) { unsigned u = __builtin_bit_cast(unsigned, f); return (u + 0x7fffu + ((u >> 16) & 1u)) >> 16; }
__device__ __forceinline__ unsigned pk2(float lo, float hi) { return f2bf(lo) | (f2bf(hi) << 16); }

#define XB_TMO      128
#define XB_XCNT(j)  (256  + 64 * (j))
#define XB_XSUB(j)  (1280 + 64 * (j))
#define XB_XGEN(j)  (2304 + 64 * (j))
#define XB_TOP      3328
#define XB_TOPGEN   3392
#define XCD_BAR_WORDS 3456
#define XB_GMASK(j)  (3456 + 64 * (j))
#define XB_LCNT(j)   (3968 + 64 * (j))
#define XCD_BAR_STRIDE 4480
#define XB_SPIN_CAP (1u << 18)

__device__ __forceinline__ unsigned xb_ld(unsigned* p)              { return __hip_atomic_load(p, __ATOMIC_RELAXED, __HIP_MEMORY_SCOPE_AGENT); }
__device__ __forceinline__ unsigned xb_add(unsigned* p, unsigned v) { return __hip_atomic_fetch_add(p, v, __ATOMIC_RELAXED, __HIP_MEMORY_SCOPE_AGENT); }
__device__ __forceinline__ unsigned xb_xcc_id() { return (unsigned)__builtin_amdgcn_s_getreg((3 << 11) | 20) & 0xFu; }
#define XB_SPIN(cond, bar) do { unsigned _sp = 0; while (cond) { __builtin_amdgcn_s_sleep(1); \
    if ((++_sp & 255u) == 0u) { if (xb_ld(&(bar)[XB_TMO])) break; if (_sp > XB_SPIN_CAP) { atomicAdd(&(bar)[XB_TMO], 1u); break; } } } } while (0)

struct XcdBarrier {
    unsigned* bar; unsigned x;
    volatile LAS unsigned* st;
};

__device__ __forceinline__ XcdBarrier xcd_barrier_post(unsigned* bar, volatile LAS unsigned* st) {
    XcdBarrier b; b.bar = bar; b.x = xb_xcc_id(); b.st = st;
    if (threadIdx.x == 0) { (void)xb_add(&bar[XB_XCNT(b.x)], 1u); (void)__hip_atomic_fetch_or(&bar[XB_GMASK(blockIdx.x & 7u)], 1u << b.x, __ATOMIC_RELAXED, __HIP_MEMORY_SCOPE_AGENT); }
    return b;
}
__device__ __forceinline__ void xcd_barrier_complete(unsigned* bar, unsigned x, unsigned& nloc, unsigned& nx) {
    const unsigned G = gridDim.x * gridDim.y * gridDim.z;
    unsigned sum, cnt, mine, sp = 0u;
    for (;;) {
        sum = 0u; cnt = 0u; mine = 0u;
#pragma unroll
        for (unsigned j = 0; j < 16; ++j) { const unsigned c = xb_ld(&bar[XB_XCNT(j)]); sum += c; cnt += (c > 0u) ? 1u : 0u; mine = (j == x) ? c : mine; }
        if (sum == G) break;
        __builtin_amdgcn_s_sleep(1);
        if ((++sp & 255u) == 0u) { if (xb_ld(&bar[XB_TMO])) break; if (sp > XB_SPIN_CAP) { atomicAdd(&bar[XB_TMO], 1u); break; } }
    }
    nloc = mine > 0u ? mine : 1u; nx = cnt > 0u ? cnt : 1u;
}

__device__ __forceinline__ void xcd_barrier(const XcdBarrier& b) {
    asm volatile("s_waitcnt vmcnt(0)" ::: "memory");
    __syncthreads();
    if (threadIdx.x == 0) {
        unsigned* bar = b.bar;
        __builtin_amdgcn_s_waitcnt(0);
        unsigned nloc = b.st[0], nx = b.st[1];
        if (nloc == 0u) { xcd_barrier_complete(bar, b.x, nloc, nx); b.st[0] = nloc; b.st[1] = nx; }
        const unsigned old = xb_add(&bar[XB_XSUB(b.x)], 1u);
        const unsigned gen = old / nloc;
        if (old + 1u == (gen + 1u) * nloc) {
            __builtin_amdgcn_fence(__ATOMIC_RELEASE, "agent");
            asm volatile("s_waitcnt vmcnt(0)" ::: "memory");
            const unsigned og = xb_add(&bar[XB_TOP], 1u);
            const unsigned tg = og / nx;
            if (og + 1u == (tg + 1u) * nx) xb_add(&bar[XB_TOPGEN], 1u);
            else XB_SPIN(xb_ld(&bar[XB_TOPGEN]) == tg, bar);
            __builtin_amdgcn_fence(__ATOMIC_ACQUIRE, "agent");
            xb_add(&bar[XB_XGEN(b.x)], 1u);
            asm volatile("s_waitcnt vmcnt(0)" ::: "memory");
        } else {
            XB_SPIN(xb_ld(&bar[XB_XGEN(b.x)]) == gen, bar);
            __builtin_amdgcn_fence(__ATOMIC_ACQUIRE, "agent");
            asm volatile("s_waitcnt vmcnt(0)" ::: "memory");
        }
    }
    __syncthreads();
}

__device__ __forceinline__ void grp_barrier(const XcdBarrier& b) {
    asm volatile("s_waitcnt vmcnt(0)" ::: "memory");
    __syncthreads();
    bool done = false;
    if (threadIdx.x == 0) {
        unsigned* bar = b.bar;
        __builtin_amdgcn_s_waitcnt(0);
        unsigned mode = b.st[2];
        if (mode == 0u) {
            bool ok = (gridDim.x == 256u);
#pragma unroll
            for (unsigned j = 0; j < 8; ++j) { const unsigned m = xb_ld(&bar[XB_GMASK(j)]); ok = ok && (m != 0u) && ((m & (m - 1u)) == 0u); }
            mode = ok ? 1u : 2u; b.st[2] = mode;
        }
        if (mode == 1u) {
            unsigned* cnt = &bar[XB_LCNT(blockIdx.x & 7u)];
            const unsigned old = xb_add(cnt, 1u); const unsigned target = (old / 32u + 1u) * 32u;
            XB_SPIN(xb_ld(cnt) < target, bar);
            __builtin_amdgcn_fence(__ATOMIC_ACQUIRE, "agent");
            asm volatile("s_waitcnt vmcnt(0)" ::: "memory");
        }
        b.st[3] = mode;
    }
    __syncthreads();
    if (b.st[3] != 1u) xcd_barrier(b);
}
constexpr int NWAVES = 8;
constexpr int M = 16384, SEQ = 4096, DM = 1024, FF = 2816, INC = 2568, NMEM = 256;
constexpr float EPS = 1e-6f;
constexpr float LOG2E = 1.4426950408889634f;
constexpr float C2 = 0.125f * LOG2E, C2C = 0.0625f * LOG2E;
constexpr size_t MiB = 1u << 20;
constexpr size_t WS_CTL = 0, CTL_ZERO_BYTES = 1 * MiB;
constexpr size_t SS_OFF = 512 * 1024;
constexpr size_t WS_W1IN = 2 * MiB, WS_WCKV = 13 * MiB, WS_W1OUT = 17 * MiB, WS_WIN = 22 * MiB + 512 * 1024, WS_WOUT = 27 * MiB + 512 * 1024, WS_WCQ = 29 * MiB + 512 * 1024, WS_WCO = 31 * MiB + 512 * 1024,
                 WS_W2IN = 33 * MiB + 512 * 1024, WS_W2OUT = 44 * MiB + 512 * 1024;
constexpr size_t WS_XN = 50 * MiB, WS_MN = 82 * MiB, WS_KVRAW = 84 * MiB, WS_LOGF = 88 * MiB, WS_CUM = 88 * MiB + 512 * 1024;
constexpr size_t WS_Y = 90 * MiB, WS_ACT = 122 * MiB;
constexpr size_t WS_Q = 122 * MiB, WS_K = 138 * MiB, WS_V = 154 * MiB, WS_U = 170 * MiB, WS_VG = 186 * MiB, WS_QC = WS_Y, WS_OC = WS_Y  , WS_KC = 210 * MiB, WS_VT = 212 * MiB, WS_END = 214 * MiB;
static_assert(WS_WCKV == WS_W1IN + (size_t)2 * FF * DM * 2, "Wckv copy must follow W1in copy (combined GEMM phase)");
static_assert(WS_MN == WS_XN + (size_t)M * DM * 2, "MN must follow XN (combined GEMM phase)");
constexpr int CW_BAR = 4096, CW_AQ = 2048;
constexpr int RING_OFF = 0, LDSCTL_OFF = 139264, MISC_OFF = LDSCTL_OFF + 320, LDS_BYTES = 143360;
static_assert(attn_body::ATTN_LDS_BYTES <= LDSCTL_OFF && pg8::STAGE_BYTES <= LDSCTL_OFF, "LDS map");

struct Frame {
    LAS unsigned char* lds; volatile LAS unsigned* MISC; gu32* ctl;
    int tid, lane, wave, vcu, G;
};
struct Args { const float* in[26]; float* out; unsigned char* ws; int ph_lo, ph_hi, li, pad; };

__device__ __forceinline__ float wave_sum(float v) {
#pragma unroll
    for (int o = 1; o < 64; o <<= 1) v += __shfl_xor(v, o);
    return v;
}
__device__ __forceinline__ void p0_transpose_item(const float* W, int ldw, int K, int src_col0, bf16* WT, int dst_row0, LAS float* scr, int kb, int lane, const float* gk = nullptr) {
    const int k0 = 64 * kb;
#pragma unroll
    for (int i = 0; i < 32; ++i) { const int kk = 2 * i + (lane >> 5); scr[kk * 33 + (lane & 31)] = __builtin_nontemporal_load(W + (size_t)(k0 + kk) * ldw + src_col0 + (lane & 31)) * (gk ? gk[k0 + kk] : 1.f); }
    LDS_WAIT(); asm volatile("" ::: "memory");
    const int c = lane & 7;
#pragma unroll
    for (int j = 0; j < 4; ++j) { const int n = (lane >> 3) + 8 * j; const LAS float* s = scr + (8 * c) * 33 + n;
        v4u o; o.x = pk2(s[0 * 33], s[1 * 33]); o.y = pk2(s[2 * 33], s[3 * 33]); o.z = pk2(s[4 * 33], s[5 * 33]); o.w = pk2(s[6 * 33], s[7 * 33]);
        *(GAS v4u*)(WT + (size_t)(dst_row0 + n) * K + k0 + 8 * c) = o; }
    LDS_WAIT(); asm volatile("" ::: "memory");
}
__device__ __forceinline__ int ffn_src_col(int db) { const int pn = db >> 3, w = db & 7; return (w >> 2) * FF + 128 * pn + 32 * (w & 3); }
__device__ __forceinline__ int mix_src_col(int db) { const int pn = db >> 3, w = db & 7;
    if (pn < 4) return (pn < 2 ? 0 : 512) + 256 * (pn & 1) + 64 * (w & 3) + 32 * (w >> 2);
    if (pn < 6) return 1024 + 256 * (pn - 4) + 32 * w;
    return 1544 + 256 * (pn - 6) + 32 * w; }
__device__ __forceinline__ void rms_row_to_bf16(int lane, const float* xrow, const float* g, bf16* orow) {
    const GAS f32x4* xr = (const GAS f32x4*)xrow + lane; const GAS f32x4* gr = (const GAS f32x4*)g + lane;
    f32x4 v[4]; float s = 0.f;
#pragma unroll
    for (int j = 0; j < 4; ++j) { v[j] = xr[64 * j]; s += (v[j].x * v[j].x + v[j].y * v[j].y) + (v[j].z * v[j].z + v[j].w * v[j].w); }
    const float rstd = rsqrtf(wave_sum(s) * (1.f / DM) + EPS);
    GAS unsigned long long* o8 = (GAS unsigned long long*)orow + lane;
#pragma unroll
    for (int j = 0; j < 4; ++j) { const f32x4 gg = gr[64 * j]; o8[64 * j] = (unsigned long long)pk2(v[j].x * rstd * gg.x, v[j].y * rstd * gg.y) | ((unsigned long long)pk2(v[j].z * rstd * gg.z, v[j].w * rstd * gg.w) << 32); }
}
constexpr int TI0 = 16 * 176, TI1 = 16 * 64, TI2 = 44 * 32, TI3 = 16 * 80, TI4 = 16 * 32;
constexpr int IG0 = TI0 + TI1 + TI2, IG1 = IG0 + TI3 + 3 * TI4, IG2 = IG1 + TI0 + TI2;
__device__ __forceinline__ void transpose_range(Frame& F, const Args& a, int first, int last, int gw, int ngw) {
    LAS float* scr = (LAS float*)(F.lds + RING_OFF + F.wave * 16384);
    unsigned char* ws = a.ws;
    for (int it = first + gw; it < last; it += ngw) {
        int r = it;
        if (r < TI0) { const int kb = r / 176, db = r % 176; p0_transpose_item(a.in[3], 2 * FF, DM, ffn_src_col(db), (bf16*)(ws + WS_W1IN), 32 * db, scr, kb, F.lane); continue; } r -= TI0;
        if (r < TI1) { const int kb = r / 64, db = r % 64; p0_transpose_item(a.in[19], 2048, DM, 32 * db, (bf16*)(ws + WS_WCKV), 32 * db, scr, kb, F.lane); continue; } r -= TI1;
        if (r < TI2) { const int kb = r / 32, db = r % 32; p0_transpose_item(a.in[4], DM, FF, 32 * db, (bf16*)(ws + WS_W1OUT), 32 * db, scr, kb, F.lane); continue; } r -= TI2;
        if (r < TI3) { const int kb = r / 80, db = r % 80; p0_transpose_item(a.in[6], INC, DM, mix_src_col(db), (bf16*)(ws + WS_WIN), 32 * db, scr, kb, F.lane, a.in[5]); continue; } r -= TI3;
        if (r < TI4) { const int kb = r / 32, db = r % 32; p0_transpose_item(a.in[15], DM, DM, 32 * db, (bf16*)(ws + WS_WOUT), 32 * db, scr, kb, F.lane); continue; } r -= TI4;
        if (r < TI4) { const int kb = r / 32, db = r % 32; p0_transpose_item(a.in[18], DM, DM, 32 * db, (bf16*)(ws + WS_WCQ), 32 * db, scr, kb, F.lane, a.in[16]); continue; } r -= TI4;
        if (r < TI4) { const int kb = r / 32, db = r % 32; p0_transpose_item(a.in[22], DM, DM, 32 * db, (bf16*)(ws + WS_WCO), 32 * db, scr, kb, F.lane); continue; } r -= TI4;
        if (r < TI0) { const int kb = r / 176, db = r % 176; p0_transpose_item(a.in[24], 2 * FF, DM, ffn_src_col(db), (bf16*)(ws + WS_W2IN), 32 * db, scr, kb, F.lane, a.in[23]); continue; } r -= TI0;
        { const int kb = r / 32, db = r % 32; p0_transpose_item(a.in[25], DM, FF, 32 * db, (bf16*)(ws + WS_W2OUT), 32 * db, scr, kb, F.lane); }
    }
}
__device__ __forceinline__ void rms_2rows_to_bf16(int lane, const float* xa, const float* ga, bf16* oa, const float* xb, const float* gb, bf16* ob) {
    const GAS f32x4* xra = (const GAS f32x4*)xa + lane; const GAS f32x4* xrb = (const GAS f32x4*)xb + lane;
    f32x4 va[4], vb[4]; float sa = 0.f, sb = 0.f;
#pragma unroll
    for (int j = 0; j < 4; ++j) { va[j] = __builtin_nontemporal_load(xra + 64 * j); vb[j] = __builtin_nontemporal_load(xrb + 64 * j); }
#pragma unroll
    for (int j = 0; j < 4; ++j) { sa += (va[j].x * va[j].x + va[j].y * va[j].y) + (va[j].z * va[j].z + va[j].w * va[j].w); sb += (vb[j].x * vb[j].x + vb[j].y * vb[j].y) + (vb[j].z * vb[j].z + vb[j].w * vb[j].w); }
    const float ra = rsqrtf(wave_sum(sa) * (1.f / DM) + EPS), rb = rsqrtf(wave_sum(sb) * (1.f / DM) + EPS);
    const GAS f32x4* gra = (const GAS f32x4*)ga + lane; const GAS f32x4* grb = (const GAS f32x4*)gb + lane;
    GAS unsigned long long* o8a = (GAS unsigned long long*)oa + lane; GAS unsigned long long* o8b = (GAS unsigned long long*)ob + lane;
#pragma unroll
    for (int j = 0; j < 4; ++j) { const f32x4 gg = gra[64 * j]; o8a[64 * j] = (unsigned long long)pk2(va[j].x * ra * gg.x, va[j].y * ra * gg.y) | ((unsigned long long)pk2(va[j].z * ra * gg.z, va[j].w * ra * gg.w) << 32); }
#pragma unroll
    for (int j = 0; j < 4; ++j) { const f32x4 gg = grb[64 * j]; o8b[64 * j] = (unsigned long long)pk2(vb[j].x * rb * gg.x, vb[j].y * rb * gg.y) | ((unsigned long long)pk2(vb[j].z * rb * gg.z, vb[j].w * rb * gg.w) << 32); }
}
__device__ __forceinline__ void p0_prologue(Frame& F, const Args& a) {
    const int gw = F.vcu * NWAVES + F.wave, NGW = F.G * NWAVES;
    transpose_range(F, a, 0, IG0, gw, NGW);
    bf16* XN = (bf16*)(a.ws + WS_XN);
    for (int m = gw; m < M + 1024; m += 2 * NGW) {
        const int m2 = m + NGW; const bool has2 = m2 < M + 1024;
        const float* xa = m < M ? a.in[0] + (size_t)m * DM : a.in[1] + (size_t)(m - M) * DM; const float* ga = m < M ? a.in[2] : a.in[17];
        const float* xb = !has2 ? xa : (m2 < M ? a.in[0] + (size_t)m2 * DM : a.in[1] + (size_t)(m2 - M) * DM); const float* gb = (has2 && m2 >= M) ? a.in[17] : (has2 ? a.in[2] : ga);
        rms_2rows_to_bf16(F.lane, xa, ga, XN + (size_t)m * DM, xb, gb, XN + (size_t)(has2 ? m2 : m) * DM);
    }
}
__device__ __forceinline__ void p3_prelude(Frame& F, const Args& a, int gw, int ngw) {
    unsigned char* ws = a.ws; const int lane = F.lane;
    const bf16* XN = (const bf16*)(ws + WS_XN); const float* ss2 = (const float*)(ws + SS_OFF); float* LOGF = (float*)(ws + WS_LOGF);
    {
        f32x4 wf[16][2];
        const float* wp = a.in[6] + (size_t)(16 * lane) * INC + 1536;
#pragma unroll
        for (int kk = 0; kk < 16; ++kk) { const float gm = a.in[5][16 * lane + kk]; wf[kk][0] = *(const f32x4*)(wp + (size_t)kk * INC) * gm; wf[kk][1] = *(const f32x4*)(wp + (size_t)kk * INC + 4) * gm; }
        const float bfl = a.in[7][lane & 7];
        for (int mb = gw; mb < M; mb += 4 * ngw) {
          v4u xq[4][2];
#pragma unroll
          for (int r = 0; r < 4; ++r) { const int m = mb + r * ngw < M ? mb + r * ngw : mb; xq[r][0] = *(const GAS v4u*)(XN + (size_t)m * DM + 16 * lane); xq[r][1] = *(const GAS v4u*)(XN + (size_t)m * DM + 16 * lane + 8); }
#pragma unroll
          for (int r = 0; r < 4; ++r) { const int m = mb + r * ngw; if (m >= M) break;
            const v4u x0 = xq[r][0], x1 = xq[r][1];
            f32x4 d0 = {0.f, 0.f, 0.f, 0.f}, d1 = {0.f, 0.f, 0.f, 0.f};
#pragma unroll
            for (int e = 0; e < 4; ++e) { const float lo = __uint_as_float(x0[e] << 16), hi = __uint_as_float(x0[e] & 0xffff0000u);
                d0 += wf[2 * e][0] * lo + wf[2 * e + 1][0] * hi; d1 += wf[2 * e][1] * lo + wf[2 * e + 1][1] * hi; }
#pragma unroll
            for (int e = 0; e < 4; ++e) { const float lo = __uint_as_float(x1[e] << 16), hi = __uint_as_float(x1[e] & 0xffff0000u);
                d0 += wf[8 + 2 * e][0] * lo + wf[8 + 2 * e + 1][0] * hi; d1 += wf[8 + 2 * e][1] * lo + wf[8 + 2 * e + 1][1] * hi; }
#pragma unroll
            for (int h = 0; h < 4; ++h) { d0[h] = wave_sum(d0[h]); d1[h] = wave_sum(d1[h]); }
            const int hsel = lane & 7;
            float mine = d0[0];
            mine = hsel == 1 ? d0[1] : mine; mine = hsel == 2 ? d0[2] : mine; mine = hsel == 3 ? d0[3] : mine;
            mine = hsel == 4 ? d1[0] : mine; mine = hsel == 5 ? d1[1] : mine; mine = hsel == 6 ? d1[2] : mine; mine = hsel == 7 ? d1[3] : mine;
            const float y = mine * rsqrtf(ss2[m] * (1.f / DM) + EPS) + bfl;
            const float lf = fminf(y, 0.f) - log1pf(expf(-fabsf(y)));
            if (lane < 8) LOGF[(size_t)((m >> 12) * 8 + lane) * SEQ + (m & 4095)] = lf;
          }
        }
    }
    const bf16* KV = (const bf16*)(ws + WS_KVRAW); bf16* KC = (bf16*)(ws + WS_KC); bf16* VT = (bf16*)(ws + WS_VT);
    for (int task = gw; task < 4096; task += ngw) {
        const int mr = task >> 2, h = task & 3; const unsigned long long raw = *(const GAS unsigned long long*)(KV + (size_t)mr * 2048 + h * 256 + 4 * lane);
        const float v0 = __uint_as_float((unsigned)raw << 16), v1 = __uint_as_float((unsigned)raw & 0xffff0000u), v2 = __uint_as_float((unsigned)(raw >> 32) << 16), v3 = __uint_as_float((unsigned)(raw >> 32) & 0xffff0000u);
        const float rs = rsqrtf(wave_sum((v0 * v0 + v1 * v1) + (v2 * v2 + v3 * v3)) * (1.f / 256.f) + EPS); const f32x4 g = *(const f32x4*)(a.in[21] + 4 * lane);
        *(GAS unsigned long long*)(KC + (size_t)mr * DM + h * 256 + 4 * lane) = (unsigned long long)pk2(v0 * rs * g.x, v1 * rs * g.y) | ((unsigned long long)pk2(v2 * rs * g.z, v3 * rs * g.w) << 32);
    }
    for (int L = gw * 64 + lane; L < 131072; L += ngw * 64) {
        const int c = L & 1023, j0 = ((L >> 10) & 31) * 8, b = L >> 15; v4u o;
#pragma unroll
        for (int i = 0; i < 4; ++i) o[i] = (unsigned)KV[(size_t)(b * 256 + j0 + 2 * i) * 2048 + 1024 + c] | ((unsigned)KV[(size_t)(b * 256 + j0 + 2 * i + 1) * 2048 + 1024 + c] << 16);
        *(GAS v4u*)(VT + (size_t)(b * 1024 + c) * 256 + j0) = o;
    }
}
__device__ __forceinline__ void sgu_phase(Frame& F, const Args& a, bool do_ss) {
    unsigned char* ws = a.ws; int tid = threadIdx.x; asm volatile("" : "+v"(tid));
    const int lane = tid & 63, wid = __builtin_amdgcn_readfirstlane(tid >> 6), fr = lane & 15, kq = lane >> 4;
    constexpr int RS = 272;
    LAS unsigned char* Wt = F.lds; LAS unsigned char* Vt = F.lds + 128 * RS;
    const int g = F.vcu & 7;
    const bf16* U = (const bf16*)(ws + WS_U); const bf16* VG = (const bf16*)(ws + WS_VG); const float* ssv = (const float*)(ws + SS_OFF) + M; float* ssg = (float*)(ws + SS_OFF) + 3 * M; bf16* Y = (bf16*)(ws + WS_Y);
    {
        const int t = tid >> 2, s0 = (tid & 3) * 32; const float* wp = a.in[11] + (size_t)(g * 128 + t) * 128 + s0;
#pragma unroll
        for (int q = 0; q < 4; ++q) { const f32x4 x0 = *(const f32x4*)(wp + 8 * q), x1 = *(const f32x4*)(wp + 8 * q + 4); const int s = s0 + 8 * q; v4u o;
            o.x = pk2(s + 0 <= t ? x0.x : 0.f, s + 1 <= t ? x0.y : 0.f); o.y = pk2(s + 2 <= t ? x0.z : 0.f, s + 3 <= t ? x0.w : 0.f);
            o.z = pk2(s + 4 <= t ? x1.x : 0.f, s + 5 <= t ? x1.y : 0.f); o.w = pk2(s + 6 <= t ? x1.z : 0.f, s + 7 <= t ? x1.w : 0.f);
            *(LAS v4u*)(Wt + t * RS + s * 2) = o; }
    }
    const int sst = tid >> 2, d0 = (tid & 3) * 16; const float* gp = a.in[10] + g * 64 + d0;
    const int rowA = (F.vcu >> 3) * 512;
    v4u x0 = *(const GAS v4u*)(VG + (size_t)(rowA + sst) * 512 + g * 64 + d0), x1 = *(const GAS v4u*)(VG + (size_t)(rowA + sst) * 512 + g * 64 + d0 + 8); float ssq = ssv[rowA + sst];
#pragma unroll
    for (int ui = 0; ui < 4; ++ui) {
        const int row0 = rowA + ui * 128;
        {
            const float rs = rsqrtf(ssq * (1.f / 512.f) + EPS);
#pragma unroll
            for (int e = 0; e < 4; ++e) { const float lo = __uint_as_float(x0[e] << 16) * rs * gp[2 * e], hi = __uint_as_float(x0[e] & 0xffff0000u) * rs * gp[2 * e + 1];
                *(LAS unsigned short*)(Vt + (d0 + 2 * e) * RS + sst * 2) = (unsigned short)f2bf(lo); *(LAS unsigned short*)(Vt + (d0 + 2 * e + 1) * RS + sst * 2) = (unsigned short)f2bf(hi); }
#pragma unroll
            for (int e = 0; e < 4; ++e) { const float lo = __uint_as_float(x1[e] << 16) * rs * gp[8 + 2 * e], hi = __uint_as_float(x1[e] & 0xffff0000u) * rs * gp[8 + 2 * e + 1];
                *(LAS unsigned short*)(Vt + (d0 + 8 + 2 * e) * RS + sst * 2) = (unsigned short)f2bf(lo); *(LAS unsigned short*)(Vt + (d0 + 8 + 2 * e + 1) * RS + sst * 2) = (unsigned short)f2bf(hi); }
        }
        const int t = 16 * wid + fr, row = row0 + t;
        unsigned long long uu[4];
#pragma unroll
        for (int ib = 0; ib < 4; ++ib) uu[ib] = *(const GAS unsigned long long*)(U + (size_t)row * 512 + g * 64 + 16 * ib + 4 * kq);
        if (ui < 3) { const size_t nr = (size_t)(row0 + 128 + sst); x0 = *(const GAS v4u*)(VG + nr * 512 + g * 64 + d0); x1 = *(const GAS v4u*)(VG + nr * 512 + g * 64 + d0 + 8); ssq = ssv[row0 + 128 + sst]; }
        __syncthreads();
        f32x4 acc[4];
#pragma unroll
        for (int ib = 0; ib < 4; ++ib) acc[ib] = (f32x4){0.f, 0.f, 0.f, 0.f};
#pragma unroll
        for (int ks = 0; ks < 4; ++ks) { const bf16x8 wfr = *(const LAS bf16x8*)(Wt + (16 * wid + fr) * RS + (32 * ks + 8 * kq) * 2);
#pragma unroll
            for (int ib = 0; ib < 4; ++ib) { const bf16x8 vfr = *(const LAS bf16x8*)(Vt + (16 * ib + fr) * RS + (32 * ks + 8 * kq) * 2); acc[ib] = __builtin_amdgcn_mfma_f32_16x16x32_bf16(vfr, wfr, acc[ib], 0, 0, 0); } }
        const float bias = a.in[12][g * 128 + t]; float sq = 0.f;
#pragma unroll
        for (int ib = 0; ib < 4; ++ib) { const int c = g * 64 + 16 * ib + 4 * kq; const unsigned long long u8 = uu[ib];
            const float u0 = __uint_as_float((unsigned)u8 << 16), u1 = __uint_as_float((unsigned)u8 & 0xffff0000u), u2 = __uint_as_float((unsigned)(u8 >> 32) << 16), u3 = __uint_as_float((unsigned)(u8 >> 32) & 0xffff0000u);
            const float s0 = u0 * (acc[ib][0] + bias), s1 = u1 * (acc[ib][1] + bias), s2 = u2 * (acc[ib][2] + bias), s3 = u3 * (acc[ib][3] + bias); sq += (s0 * s0 + s1 * s1) + (s2 * s2 + s3 * s3);
            const f32x4 go = *(const f32x4*)(a.in[14] + c);
            *(GAS unsigned long long*)(Y + (size_t)row * 1024 + 512 + c) = (unsigned long long)pk2(s0 * go.x, s1 * go.y) | ((unsigned long long)pk2(s2 * go.z, s3 * go.w) << 32); }
        sq += __shfl_xor(sq, 16); sq += __shfl_xor(sq, 32); if (kq == 0 && do_ss) atomicAdd(ssg + row, sq);
        __syncthreads();
    }
}
__device__ __forceinline__ void xattn_units(Frame& F, const Args& a, int b, int h, int qrow0) {
    typedef short s16x4 __attribute__((ext_vector_type(4)));
    unsigned char* ws = a.ws; const int tid = F.tid, lane = F.lane, wid = F.wave, fr = lane & 15, kq = lane >> 4;
    constexpr int RS = 528;
    LAS unsigned char* L = F.lds;
    const bf16* QC = (const bf16*)(ws + WS_QC); const bf16* KC = (const bf16*)(ws + WS_KC); const bf16* VT = (const bf16*)(ws + WS_VT); bf16* OC = (bf16*)(ws + WS_OC);
    v4u st[16];
#pragma unroll
    for (int i = 0; i < 16; ++i) { const int ch = tid + 512 * i, j = ch >> 5, c16 = ch & 31; st[i] = *(const GAS v4u*)(KC + (size_t)(b * NMEM + j) * DM + h * 256 + c16 * 8); }
#pragma unroll
    for (int i = 0; i < 16; ++i) { const int ch = tid + 512 * i, j = ch >> 5, c16 = ch & 31; *(LAS v4u*)(L + j * RS + c16 * 16) = st[i]; }
    __syncthreads();
    bf16x8 pf[2][8]; float inv[2]; bf16x8 qf[2][8];
    const int rowq = b * SEQ + qrow0 + wid * 16;
#pragma unroll
    for (int hh = 0; hh < 2; ++hh)
#pragma unroll
        for (int ks = 0; ks < 8; ++ks) qf[hh][ks] = *(const GAS bf16x8*)(QC + (size_t)(rowq + hh * 128 + fr) * DM + h * 256 + 32 * ks + 8 * kq);
    float sum0 = 0.f, sum1 = 0.f;
#pragma unroll
    for (int k2 = 0; k2 < 8; ++k2) {
        f32x4 a00 = {0.f, 0.f, 0.f, 0.f}, a01 = a00, a10 = a00, a11 = a00;
#pragma unroll
        for (int ks = 0; ks < 8; ++ks) {
            const bf16x8 kA = *(const LAS bf16x8*)(L + (32 * k2 + fr) * RS + (32 * ks + 8 * kq) * 2), kB = *(const LAS bf16x8*)(L + (32 * k2 + 16 + fr) * RS + (32 * ks + 8 * kq) * 2);
            a00 = __builtin_amdgcn_mfma_f32_16x16x32_bf16(kA, qf[0][ks], a00, 0, 0, 0); a01 = __builtin_amdgcn_mfma_f32_16x16x32_bf16(kB, qf[0][ks], a01, 0, 0, 0);
            a10 = __builtin_amdgcn_mfma_f32_16x16x32_bf16(kA, qf[1][ks], a10, 0, 0, 0); a11 = __builtin_amdgcn_mfma_f32_16x16x32_bf16(kB, qf[1][ks], a11, 0, 0, 0); }
#pragma unroll
        for (int e = 0; e < 4; ++e) { a00[e] = __builtin_amdgcn_exp2f(a00[e]); a01[e] = __builtin_amdgcn_exp2f(a01[e]); a10[e] = __builtin_amdgcn_exp2f(a10[e]); a11[e] = __builtin_amdgcn_exp2f(a11[e]); }
        sum0 += (a00[0] + a00[1]) + (a00[2] + a00[3]) + (a01[0] + a01[1]) + (a01[2] + a01[3]); sum1 += (a10[0] + a10[1]) + (a10[2] + a10[3]) + (a11[0] + a11[1]) + (a11[2] + a11[3]);
        { const v4u w = {pk2(a00[0], a00[1]), pk2(a00[2], a00[3]), pk2(a01[0], a01[1]), pk2(a01[2], a01[3])}; pf[0][k2] = __builtin_bit_cast(bf16x8, w); }
        { const v4u w = {pk2(a10[0], a10[1]), pk2(a10[2], a10[3]), pk2(a11[0], a11[1]), pk2(a11[2], a11[3])}; pf[1][k2] = __builtin_bit_cast(bf16x8, w); }
    }
    sum0 += __shfl_xor(sum0, 16); sum0 += __shfl_xor(sum0, 32); sum1 += __shfl_xor(sum1, 16); sum1 += __shfl_xor(sum1, 32);
    inv[0] = 1.f / sum0; inv[1] = 1.f / sum1;
    asm volatile("" ::: "memory");
#pragma unroll
    for (int i = 0; i < 16; ++i) { const int ch = tid + 512 * i, d = ch >> 5, c16 = ch & 31; st[i] = *(const GAS v4u*)(VT + (size_t)(b * 1024 + h * 256 + d) * NMEM + c16 * 8); }
    __syncthreads();
#pragma unroll
    for (int i = 0; i < 16; ++i) { const int ch = tid + 512 * i, d = ch >> 5, c16 = ch & 31; *(LAS v4u*)(L + d * RS + c16 * 16) = st[i]; }
    __syncthreads();
#pragma unroll 2
    for (int db = 0; db < 16; ++db) { f32x4 acc0 = {0.f, 0.f, 0.f, 0.f}, acc1 = acc0;
#pragma unroll
        for (int k2 = 0; k2 < 8; ++k2) { const s16x4 lo = *(const LAS s16x4*)(L + (16 * db + fr) * RS + (32 * k2 + 4 * kq) * 2), hi = *(const LAS s16x4*)(L + (16 * db + fr) * RS + (32 * k2 + 16 + 4 * kq) * 2);
            const bf16x8 vfr = {lo[0], lo[1], lo[2], lo[3], hi[0], hi[1], hi[2], hi[3]};
            acc0 = __builtin_amdgcn_mfma_f32_16x16x32_bf16(vfr, pf[0][k2], acc0, 0, 0, 0); acc1 = __builtin_amdgcn_mfma_f32_16x16x32_bf16(vfr, pf[1][k2], acc1, 0, 0, 0); }
        *(GAS unsigned long long*)(OC + (size_t)(rowq + fr) * DM + h * 256 + 16 * db + 4 * kq) = (unsigned long long)pk2(acc0[0] * inv[0], acc0[1] * inv[0]) | ((unsigned long long)pk2(acc0[2] * inv[0], acc0[3] * inv[0]) << 32);
        *(GAS unsigned long long*)(OC + (size_t)(rowq + 128 + fr) * DM + h * 256 + 16 * db + 4 * kq) = (unsigned long long)pk2(acc1[0] * inv[1], acc1[1] * inv[1]) | ((unsigned long long)pk2(acc1[2] * inv[1], acc1[3] * inv[1]) << 32); }
    __syncthreads();
}
__global__ void __launch_bounds__(NWAVES * 64, 2) mk_fwd(Args args) {
    extern __shared__ __attribute__((aligned(16))) unsigned char lds[];
    Frame F;
    F.lds = (LAS unsigned char*)lds; F.MISC = (volatile LAS unsigned*)(F.lds + MISC_OFF);
    F.tid = threadIdx.x; F.lane = F.tid & 63; F.wave = __builtin_amdgcn_readfirstlane(F.tid >> 6);
    F.G = gridDim.x; { const int bx = blockIdx.x; F.vcu = (F.G % 8 == 0) ? (bx % 8) * (F.G / 8) + bx / 8 : bx; }
    unsigned char* ws = args.ws; F.ctl = (gu32*)(ws + WS_CTL);
    { int u0 = F.tid; asm volatile("" : "+v"(u0));
      for (int u = u0; u < (LDS_BYTES - LDSCTL_OFF) / 4; u += NWAVES * 64) ((LAS unsigned*)(F.lds + LDSCTL_OFF))[u] = 0u; }
    __syncthreads();
    XcdBarrier bar = xcd_barrier_post((unsigned*)(F.ctl + CW_BAR) + args.li * XCD_BAR_STRIDE, F.MISC + 8);
    const int lo = args.ph_lo, hi = args.ph_hi;
#ifndef PH_MASK
#define PH_MASK 0x7ff
#endif
#define IN(k) ((((PH_MASK) >> (k)) & 1) && lo <= (k) && (k) < hi)
#ifndef PROBE_BAR
#define PROBE_BAR 1
#endif
#define SEAM(k) do { if (IN(k) && IN((k) + 1)) { for (int nb_ = 0; nb_ < PROBE_BAR; ++nb_) xcd_barrier(bar); } } while (0)
#ifndef LOCAL_SEAMS
#define LOCAL_SEAMS 1
#endif
#define LSEAM(k) do { if (IN(k) && IN((k) + 1)) { if (LOCAL_SEAMS) grp_barrier(bar); else xcd_barrier(bar); } } while (0)
    float* ssb = (float*)(ws + SS_OFF); float *ss2 = ssb, *ssv = ssb + M, *ssa = ssb + 2 * M, *ssg = ssb + 3 * M, *ss3 = ssb + 4 * M, *ss4 = ssb + 5 * M;
    pg8::bf16_t* XN = (pg8::bf16_t*)(ws + WS_XN); pg8::bf16_t* ACT = (pg8::bf16_t*)(ws + WS_ACT); pg8::bf16_t* Y = (pg8::bf16_t*)(ws + WS_Y);
    float* out = args.out;
    const int bid = (int)blockIdx.x;

#ifndef PROBE_DUP
#define PROBE_DUP -1
#endif
#if PROBE_DUP >= 0
    const int rp = args.pad;
#else
    constexpr int rp = 0;
#endif
#define REPS(k)
#ifndef PROBE_PASSES
#define PROBE_PASSES 1
#endif
    if (IN(0)) { REPS(0) p0_prologue(F, args); SEAM(0); }
    if (IN(1)) {
        pg8::Gemm g{XN, (const pg8::bf16_t*)(ws + WS_W1IN), M + 1024, 2 * FF + 2048, DM}; pg8::ComboOrder S; S.init(M, 2 * FF, F.G, bid, 32, 64, 22, 4);
        pg8::EpiSwiGLU E{ACT, nullptr, (pg8::bf16_t*)(ws + WS_KVRAW), 22, 64};
        REPS(1) pg8::gemm_phase<pg8::EpiSwiGLU, pg8::ComboOrder, PG8_ALIGN, PG8_SP2>(F.lds + RING_OFF, g, S, E);
        if (bid >= 160 && rp == 0) transpose_range(F, args, IG0, IG1, (bid - 160) * NWAVES + F.wave, (F.G - 160) * NWAVES);
        LSEAM(1); }
    if (IN(2)) {
        pg8::Gemm g{ACT, (const pg8::bf16_t*)(ws + WS_W1OUT), M, DM, FF}; pg8::StaticOrder S; S.init(M, DM, F.G, bid);
        REPS(2) { pg8::EpiRes<0, false, true> E{args.in[0], XN, 0.5f, nullptr, nullptr, rp ? nullptr : ss2};
        pg8::gemm_phase<pg8::EpiRes<0, false, true>, pg8::StaticOrder, PG8_ALIGN, PG8_SP2>(F.lds + RING_OFF, g, S, E); } SEAM(2); }
    if (IN(3)) {
        REPS(3) {
        p3_prelude(F, args, F.vcu * NWAVES + F.wave, F.G * NWAVES);
        pg8::Gemm g{XN, (const pg8::bf16_t*)(ws + WS_WIN), M, 2560, DM}; pg8::StaticOrder S; S.init(M, 2560, F.G, bid);
        static_assert(WS_K - WS_Q == 16 * MiB && WS_V - WS_K == 16 * MiB && WS_U - WS_V == 16 * MiB && WS_VG - WS_U == 16 * MiB, "EpiMix addresses Q|K|V|U|VG by stride");
        pg8::EpiMix E{ss2, args.in[8], args.in[9], (pg8::bf16_t*)(ws + WS_Q), rp ? nullptr : ssv};
        pg8::gemm_phase<pg8::EpiMix, pg8::StaticOrder, PG8_ALIGN, PG8_SP2>(F.lds + RING_OFF, g, S, E); }
        if (bid >= 128 && rp == 0) transpose_range(F, args, IG1, IG2, (bid - 128) * NWAVES + F.wave, (F.G - 128) * NWAVES);
        SEAM(3); }
    if (IN(4)) {
        REPS(4) {
        const attn_body::AttnTensors AT{(const attn_body::bf16*)(ws + WS_Q), (const attn_body::bf16*)(ws + WS_K), (const attn_body::bf16*)(ws + WS_V), (unsigned short*)Y, args.in[13], rp ? nullptr : ssa, (const float*)(ws + WS_LOGF), args.in[8], args.in[9], (unsigned*)(F.ctl + CW_AQ)};
        const attn_body::StaticOrder S((int)F.G, bid);
        sgu_phase(F, args, rp == 0);
        attn_body::attn_phase<attn_body::StaticOrder>((char*)lds + RING_OFF, AT, S); } SEAM(4); }
    if (IN(5)) {
        pg8::Gemm g{Y, (const pg8::bf16_t*)(ws + WS_WOUT), M, DM, DM}; pg8::StaticOrder S; S.init(M, DM, F.G, bid);
        REPS(5) { pg8::EpiRes<8, true, true> E{XN, XN, rp ? 0.0f : 1.0f, ssg, ssa, rp ? nullptr : ss3};
        pg8::gemm_phase<pg8::EpiRes<8, true, true>, pg8::StaticOrder, PG8_ALIGN, PG8_SP2>(F.lds + RING_OFF, g, S, E); } LSEAM(5); }
    if (IN(6)) {
        pg8::Gemm g{XN, (const pg8::bf16_t*)(ws + WS_WCQ), M, DM, DM}; pg8::StaticOrder S; S.init(M, DM, F.G, bid);
        pg8::EpiCQ E{ss3, args.in[20], (pg8::bf16_t*)(ws + WS_QC)};
        REPS(6) pg8::gemm_phase<pg8::EpiCQ, pg8::StaticOrder, false, PG8_SP2>(F.lds + RING_OFF, g, S, E);
        pg8::Unit u; if (S.next(0, u)) { asm volatile("s_waitcnt vmcnt(0)" ::: "memory"); __syncthreads(); xattn_units(F, args, u.pm >> 4, u.pn, (u.pm & 15) * 256); }
        LSEAM(7); }
    if (IN(8)) {
        pg8::Gemm g{(const pg8::bf16_t*)(ws + WS_OC), (const pg8::bf16_t*)(ws + WS_WCO), M, DM, DM}; pg8::StaticOrder S; S.init(M, DM, F.G, bid);
        REPS(8) { pg8::EpiRes<0, true, true> E{XN, XN, rp ? 0.0f : 1.0f, nullptr, nullptr, rp ? nullptr : ss4};
        pg8::gemm_phase<pg8::EpiRes<0, true, true>, pg8::StaticOrder, PG8_ALIGN, PG8_SP2>(F.lds + RING_OFF, g, S, E); } LSEAM(8); }
    if (IN(9)) {
        pg8::Gemm g{XN, (const pg8::bf16_t*)(ws + WS_W2IN), M, 2 * FF, DM}; pg8::ComboOrder S; S.init(M, 2 * FF, F.G, bid, 0, 64, 22, 4);
        pg8::EpiSwiGLU E{ACT, ss4, nullptr, 22, 64};
        REPS(9) pg8::gemm_phase<pg8::EpiSwiGLU, pg8::ComboOrder, PG8_ALIGN, PG8_SP2>(F.lds + RING_OFF, g, S, E); LSEAM(9); }
    if (IN(10)) {
        pg8::Gemm g{ACT, (const pg8::bf16_t*)(ws + WS_W2OUT), M, DM, FF}; pg8::StaticOrder S; S.init(M, DM, F.G, bid);
        REPS(10) { pg8::EpiRes<0, true, false> E{XN, out, rp ? 0.0f : 0.5f, nullptr, nullptr, nullptr};
        pg8::gemm_phase<pg8::EpiRes<0, true, false>, pg8::StaticOrder, PG8_ALIGN, PG8_SP2>(F.lds + RING_OFF, g, S, E); } }
#undef IN
#undef SEAM
}
#ifndef FAST_K
#define FAST_K 11
#endif
extern "C" void kernel_launch(void* const* d_in, const int* in_sizes, int n_in, void* d_out, int out_size, void* d_ws, size_t ws_size, hipStream_t stream) {
    static int grid = 0;
    if (grid == 0) {
        if (n_in != 26 || in_sizes[0] != M * DM || out_size != M * DM || ws_size < WS_END) { fprintf(stderr, "kernel_launch: unexpected problem shape (n_in %d, in0 %d, out %d, ws %zu)\n", n_in, n_in > 0 ? in_sizes[0] : -1, out_size, ws_size); grid = -1; return; }
        int dev = 0, cus = 0, per_cu = 0;
        if (hipGetDevice(&dev) != hipSuccess || hipDeviceGetAttribute(&cus, hipDeviceAttributeMultiprocessorCount, dev) != hipSuccess) { grid = -1; return; }
        if (hipFuncSetAttribute((const void*)mk_fwd, hipFuncAttributeMaxDynamicSharedMemorySize, LDS_BYTES) != hipSuccess) { fprintf(stderr, "kernel_launch: hipFuncSetAttribute failed\n"); grid = -1; return; }
        if (hipOccupancyMaxActiveBlocksPerMultiprocessor(&per_cu, (const void*)mk_fwd, NWAVES * 64, LDS_BYTES) != hipSuccess || per_cu < 1) fprintf(stderr, "kernel_launch: occupancy query reports %d workgroups per CU\n", per_cu);
        (void)hipGetLastError();
        grid = cus;
        if (grid != 256) fprintf(stderr, "kernel_launch: %d CUs; this kernel's unit orders are built for 256\n", grid);
#if FAST_K < 11
        (void)hipFuncSetAttribute((const void*)nv::nv_ffn<true>, hipFuncAttributeMaxDynamicSharedMemorySize, 160 * 1024);
        (void)hipFuncSetAttribute((const void*)nv::nv_mixin, hipFuncAttributeMaxDynamicSharedMemorySize, 160 * 1024);
        (void)hipFuncSetAttribute((const void*)nv::nv_proj<0>, hipFuncAttributeMaxDynamicSharedMemorySize, 160 * 1024);
        (void)hipFuncSetAttribute((const void*)nv::nv_proj<1>, hipFuncAttributeMaxDynamicSharedMemorySize, 160 * 1024);
        (void)hipFuncSetAttribute((const void*)nv::nv_cq, hipFuncAttributeMaxDynamicSharedMemorySize, 160 * 1024);
        (void)hipFuncSetAttribute((const void*)nv::nv_kvmem, hipFuncAttributeMaxDynamicSharedMemorySize, 160 * 1024);
#endif
    }
    if (grid < 0) return;
    unsigned char* ws = (unsigned char*)d_ws;
    (void)hipMemsetAsync(ws + WS_CTL, 0, CTL_ZERO_BYTES, stream);
    Args a{};
    for (int i = 0; i < 26; ++i) a.in[i] = (const float*)d_in[i];
    a.out = (float*)d_out; a.ws = ws; a.ph_lo = 0; a.ph_hi = FAST_K; a.li = 0;
    hipLaunchKernelGGL(mk_fwd, dim3(grid), dim3(NWAVES * 64), LDS_BYTES, stream, a);
#if defined(PROBE_PASSES) && PROBE_PASSES > 1
    (void)hipMemsetAsync(ws + WS_CTL, 0, CTL_ZERO_BYTES, stream); hipLaunchKernelGGL(mk_fwd, dim3(grid), dim3(NWAVES * 64), LDS_BYTES, stream, a);
#endif
#if defined(PROBE_DUP) && PROBE_DUP >= 0
    (void)hipMemsetAsync(ws + WS_CTL, 0, CTL_ZERO_BYTES, stream);
    { Args b = a; b.ph_lo = PROBE_DUP; b.ph_hi = PROBE_DUP + 1; b.li = 1; b.pad = 1; hipLaunchKernelGGL(mk_fwd, dim3(grid), dim3(NWAVES * 64), LDS_BYTES, stream, b); }
#endif
#if FAST_K < 11
    {
        using namespace nv;
        const float* const* in = a.in; float* out = a.out;
        float* ssb = (float*)(ws + SS_OFF); float *ss2 = ssb, *ssv = ssb + M, *ssa = ssb + 2 * M, *ssg = ssb + 3 * M, *ss3 = ssb + 4 * M, *ss4 = ssb + 5 * M;
        nv::bf16_t* XN = (nv::bf16_t*)(ws + WS_XN); nv::bf16_t* MN = (nv::bf16_t*)(ws + WS_MN); nv::bf16_t* KC = (nv::bf16_t*)(ws + WS_KC); nv::bf16_t* VT = (nv::bf16_t*)(ws + WS_VT);
        float* LOGF = (float*)(ws + WS_LOGF); float* CUM = (float*)(ws + WS_CUM); nv::bf16_t* Y = (nv::bf16_t*)(ws + WS_Y);
        nv::bf16_t *Q = (nv::bf16_t*)(ws + WS_Q), *K = (nv::bf16_t*)(ws + WS_K), *V = (nv::bf16_t*)(ws + WS_V), *U = (nv::bf16_t*)(ws + WS_U), *VG = (nv::bf16_t*)(ws + WS_VG), *QC = (nv::bf16_t*)(ws + WS_QC), *OC = (nv::bf16_t*)(ws + WS_OC);
        if (FAST_K <= 3) { nv_kvmem<<<1024 / 8, 256, (8 * 1024 + 8 * 2048) * 4, stream>>>(MN, in[19], in[21], KC, VT);
                           nv_mixin<<<M / 8, 256, (8 * 1024 + 8 * INC) * 4, stream>>>(XN, ss2, in[6], in[7], in[8], in[9], Q, K, V, U, VG, ssv, LOGF); }
        if (FAST_K <= 4) { nv_scan<<<32, 64, 0, stream>>>(LOGF, CUM); nv_fox<<<dim3(64, 32), 64, 0, stream>>>(Q, K, V, CUM, in[13], Y, ssa);
                           nv_sgu<<<1024, 256, 0, stream>>>(U, VG, ssv, in[10], in[11], in[12], in[14], Y, ssg); }
        if (FAST_K <= 5) nv_proj<0><<<M / 8, 256, (16 * 1024) * 4, stream>>>(Y, ssa, ssg, in[15], out, in[16], XN, ss3);
        if (FAST_K <= 6) nv_cq<<<M / 8, 256, (16 * 1024) * 4, stream>>>(XN, ss3, in[18], in[20], QC);
        if (FAST_K <= 7) nv_xattn<<<M, 256, 0, stream>>>(QC, KC, VT, OC);
        if (FAST_K <= 8) nv_proj<1><<<M / 8, 256, (16 * 1024) * 4, stream>>>(OC, nullptr, nullptr, in[22], out, in[23], XN, ss4);
        if (FAST_K <= 10) nv_ffn<true><<<M / 8, 256, (8 * 1024 + 8 * FF) * 4, stream>>>(XN, ss4, out, in[24], in[25], out, nullptr, nullptr, nullptr);
    }
#endif
}
```

```cpp
#include <hip/hip_runtime.h>
#include <hip/hip_bf16.h>
#include <cstdio>
#include <cstdint>
#include <cmath>
namespace pg8 {
#define PG8_LAS __attribute__((address_space(3)))
typedef unsigned short bf16_t;
typedef short bf16x8 __attribute__((ext_vector_type(8)));
typedef float f32x4 __attribute__((ext_vector_type(4)));
typedef unsigned u32x4 __attribute__((ext_vector_type(4)));
constexpr int BM = 256, BK = 64, HALF = 128, HTB = HALF * BK * 2  , STAGE_BYTES = 8 * HTB, NXCD = 8, WGM = 8;

__host__ __device__ __forceinline__ int lds_byte(int r, int c) { const int st = (r >> 4) * 2 + (c >> 5), rr = r & 15, cc = c & 31, ob = rr * 64 + cc * 2; return st * 1024 + (ob ^ (((ob >> 9) & 1) << 5)); }
__host__ __device__ __forceinline__ void stage_rc(int b, int& R, int& C) { const int st = b / 1024, sb = b % 1024, swz = sb ^ (((sb >> 9) & 1) << 5); R = (st >> 1) * 16 + swz / 64; C = (st & 1) * 32 + (swz % 64) / 2; }
__host__ __device__ __forceinline__ int perm32(int rho) { const int n = rho >> 4, i = rho & 15; return 8 * (i >> 2) + 4 * n + (i & 3); }

struct Unit { int pm, pn; };
__host__ __device__ __forceinline__ int unit_pn(const Unit& u) { return u.pn & 0xffff; }
__host__ __device__ __forceinline__ int unit_hm(const Unit& u) { return (u.pn >> 16) - 1; }
struct Gemm { const bf16_t* A; const bf16_t* Bt; int M, N, K; };

struct StaticOrder {
    int nM, nN, nwg, G, c;
    __host__ __device__ void init(int M, int N, int G_, int c_) { nM = M / BM; nN = N / BM; nwg = nM * nN; G = G_; c = c_; }
    __host__ __device__ __forceinline__ bool next(int i, Unit& u) const {
        const long L = (long)i * G + c; return at(L, u); }
    __host__ __device__ __forceinline__ bool at(long L, Unit& u) const {
        if (L >= nwg) return false;
        int wgid = (int)L; { const int q = nwg / NXCD, r = nwg % NXCD, xcd = wgid % NXCD, off = wgid / NXCD; wgid = (xcd < r ? xcd * (q + 1) : r * (q + 1) + (xcd - r) * q) + off; }
        const int nig = WGM * nN, gid = wgid / nig, fm = gid * WGM, gsz = (nM - fm) < WGM ? (nM - fm) : WGM;
        u.pm = fm + ((wgid % nig) % gsz); u.pn = (wgid % nig) / gsz; return true;
    }
    __device__ __forceinline__ void a_ready(const Unit&) const {}
    __device__ __forceinline__ void done(const Unit&) const {}
};
struct HalfTailOrder {
    StaticOrder so; int R;
    __host__ __device__ void init(int M, int N, int G_, int c_) { so.init(M, N, G_, c_); R = so.nwg / G_; }
    __host__ __device__ __forceinline__ bool next(int i, Unit& u) const {
        if (i < R) return so.next(i, u);
        if (i > R || (so.nwg - R * so.G) * 2 != so.G) return false;
        const int g = so.c & 7, k = so.c >> 3; const bool ok = so.at((long)R * so.G + g + 8 * (k >> 1), u); u.pn |= ((k & 1) + 1) << 16; return ok; }
    __device__ __forceinline__ void a_ready(const Unit&) const {}
    __device__ __forceinline__ void done(const Unit&) const {}
};

__device__ __forceinline__ unsigned cvt_pk_bf16(float lo, float hi) { unsigned r; asm volatile("v_cvt_pk_bf16_f32 %0, %1, %2" : "=v"(r) : "v"(lo), "v"(hi)); return r; }
typedef float f32x2 __attribute__((ext_vector_type(2)));
__device__ __forceinline__ f32x2 gelu_pk(f32x2 v) {
    const f32x2 av = __builtin_elementwise_abs(v), d = av * 0.2316418882f + 1.0f;
    f32x2 t; t.x = __builtin_amdgcn_rcpf(d.x); t.y = __builtin_amdgcn_rcpf(d.y);
    f32x2 q = t * 0.5307027145f + (-0.7265760135f); q = q * t + 0.7107068705f; q = q * t + (-0.142248368f); q = q * t + 0.127414796f; q = q * t;
    const f32x2 s = (v * v) * (-0.72134752044f);
    f32x2 e; e.x = __builtin_amdgcn_exp2f(s.x); e.y = __builtin_amdgcn_exp2f(s.y);
    const f32x2 m = v * (q * e), r = v - m;
    f32x2 o; o.x = v.x < 0.f ? m.x : r.x; o.y = v.y < 0.f ? m.y : r.y; return o;
}

template <int ACT  > struct EpiBf16 {
    static constexpr bool PERM = true, AFTER_DRAIN = false; static_assert(ACT == 0 || ACT == 1, "EpiBf16: ACT is 0 (none) or 1 (gelu_pk)");
    bf16_t* O; int ldc; const float* bias; int split_cols; size_t split_stride; float scale0;
    __device__ __forceinline__ void operator()(const f32x4 (&acc)[2][2][4][2], const Unit& u, int wr, int wc, int fr, int fq) const {
        const int row0 = u.pm * BM + wr * 64 + fr; int colt = u.pn * BM; bf16_t* base = O;
        float sc = 1.f; if (split_cols) { const int t = colt / split_cols; base += (size_t)t * split_stride; colt -= t * split_cols; if (t == 0) sc = scale0; }
        const int col0 = colt + wc * 32 + 8 * fq, bcol0 = u.pn * BM + wc * 32 + 8 * fq;
        f32x4 bv[2][2];
#pragma unroll
        for (int bj = 0; bj < 2; ++bj)
#pragma unroll
            for (int n = 0; n < 2; ++n) bv[bj][n] = bias ? *(const f32x4*)(bias + bcol0 + bj * HALF + 4 * n) : (f32x4){0.f, 0.f, 0.f, 0.f};
#pragma unroll
        for (int ai = 0; ai < 2; ++ai)
#pragma unroll
            for (int m = 0; m < 4; ++m) { bf16_t* rowp = base + (size_t)(row0 + ai * HALF + m * 16) * ldc + col0;
#pragma unroll
                for (int bj = 0; bj < 2; ++bj) { f32x4 v0 = acc[ai][bj][m][0] + bv[bj][0], v1 = acc[ai][bj][m][1] + bv[bj][1];
                    if (ACT == 1) { f32x2 a = gelu_pk((f32x2){v0[0], v0[1]}), b = gelu_pk((f32x2){v0[2], v0[3]}), c = gelu_pk((f32x2){v1[0], v1[1]}), d = gelu_pk((f32x2){v1[2], v1[3]});
                        v0 = (f32x4){a.x, a.y, b.x, b.y}; v1 = (f32x4){c.x, c.y, d.x, d.y}; }
                    v0 = v0 * sc; v1 = v1 * sc; u32x4 w; w.x = cvt_pk_bf16(v0[0], v0[1]); w.y = cvt_pk_bf16(v0[2], v0[3]); w.z = cvt_pk_bf16(v1[0], v1[1]); w.w = cvt_pk_bf16(v1[2], v1[3]);
                    *(u32x4*)(rowp + bj * HALF) = w; } }
    }
};
constexpr float K_EPS = 1e-6f, K_LOG2E = 1.4426950408889634f;
constexpr float K_C2 = 0.125f * K_LOG2E;
constexpr float K_C2C = 0.0625f * K_LOG2E;
__device__ __forceinline__ float silu_f(float x) { return x * __builtin_amdgcn_rcpf(1.f + __builtin_amdgcn_exp2f(-x * K_LOG2E)); }
__device__ __forceinline__ float gelu_tanh_f(float x) { const float z2 = x * (1.5957691216057308f + 0.0713548162726009f * x * x); return x * __builtin_amdgcn_rcpf(1.f + __builtin_amdgcn_exp2f(-z2 * K_LOG2E)); }
__device__ __forceinline__ u32x4 pack8(const f32x4 v0, const f32x4 v1) { u32x4 w; w.x = cvt_pk_bf16(v0[0], v0[1]); w.y = cvt_pk_bf16(v0[2], v0[3]); w.z = cvt_pk_bf16(v1[0], v1[1]); w.w = cvt_pk_bf16(v1[2], v1[3]); return w; }
#ifndef WT_STORES
#define WT_STORES 0
#endif
__device__ __forceinline__ void st16(void* p, u32x4 v) {
#if WT_STORES
    asm volatile("global_store_dwordx4 %0, %1, off sc1\n\ts_nop 1" :: "v"(p), "v"(v) : "memory");
#else
    *(u32x4*)p = v;
#endif
}
typedef unsigned u32x2_t __attribute__((ext_vector_type(2)));
__device__ __forceinline__ void st8(void* p, u32x2_t v) {
#if WT_STORES
    asm volatile("global_store_dwordx2 %0, %1, off sc1\n\ts_nop 1" :: "v"(p), "v"(v) : "memory");
#else
    *(u32x2_t*)p = v;
#endif
}
__device__ __forceinline__ void st16f(void* p, f32x4 v) { st16(p, __builtin_bit_cast(u32x4, v)); }
__device__ __forceinline__ float sumsq4(const f32x4 v) { return (v[0] * v[0] + v[1] * v[1]) + (v[2] * v[2] + v[3] * v[3]); }

struct ComboOrder {
    StaticOrder so; int nmain, nextra, xm0, xn0, xnm;
    __host__ __device__ void init(int M, int N, int G_, int c_, int nextra_, int xm0_, int xn0_, int xnm_) { so.init(M, N, G_, c_); nmain = so.nwg; nextra = nextra_; xm0 = xm0_; xn0 = xn0_; xnm = xnm_; }
    __host__ __device__ __forceinline__ bool next(int i, Unit& u) const {
        const long L = (long)i * so.G + so.c; if (L < nmain) return so.next(i, u);
        const int j = (int)(L - nmain); if (j >= nextra) return false; u.pm = xm0 + j % xnm; u.pn = xn0 + j / xnm; return true; }
    __device__ __forceinline__ void a_ready(const Unit&) const {}
    __device__ __forceinline__ void done(const Unit&) const {}
};

struct EpiSwiGLU {
    static constexpr bool PERM = true, AFTER_DRAIN = false; static constexpr int MIDK = 0;
    bf16_t* ACT; const float* ss; bf16_t* KV; int nmain_n, nmain_m;
    __device__ __forceinline__ void midk(f32x4 (&)[2][2][4][2], const Unit&, int, int) const {}
    __device__ __forceinline__ void operator()(const f32x4 (&acc)[2][2][4][2], const Unit& u, int wr, int wc, int fr, int fq) const {
        const int rowl = wr * 64 + fr;
        if (unit_pn(u) >= nmain_n) {
            const int col0 = (unit_pn(u) - nmain_n) * BM + wc * 32 + 8 * fq;
#pragma unroll
            for (int ai = 0; ai < 2; ++ai)
#pragma unroll
                for (int m = 0; m < 4; ++m) { bf16_t* rowp = KV + (size_t)((u.pm - nmain_m) * BM + rowl + ai * HALF + m * 16) * 2048 + col0;
#pragma unroll
                    for (int bj = 0; bj < 2; ++bj) st16(rowp + bj * HALF, pack8(acc[ai][bj][m][0], acc[ai][bj][m][1])); }
            return;
        }
        const int col0 = unit_pn(u) * HALF + wc * 32 + 8 * fq; const int hoff = unit_hm(u) > 0 ? HALF : 0, nai = unit_hm(u) < 0 ? 2 : 1;
#pragma unroll
        for (int ai = 0; ai < 2; ++ai) if (ai < nai)
#pragma unroll
            for (int m = 0; m < 4; ++m) { const int row = u.pm * BM + hoff + rowl + ai * HALF + m * 16; const float rs = ss ? rsqrtf(ss[row] * (1.f / 1024.f) + K_EPS) : 1.f;
                f32x4 h[2];
#pragma unroll
                for (int n = 0; n < 2; ++n) { const f32x4 g = acc[ai][0][m][n] * rs, uu = acc[ai][1][m][n] * rs;
#pragma unroll
                    for (int e = 0; e < 4; ++e) h[n][e] = silu_f(g[e]) * uu[e]; }
                st16(ACT + (size_t)row * 2816 + col0, pack8(h[0], h[1])); }
    }
};

template <int MIDK_, bool XRES_BF16, bool OUT_BF16> struct EpiRes {
    static constexpr bool PERM = true, AFTER_DRAIN = false; static constexpr int MIDK = MIDK_;
    const void* xres; void* out; float scale; const float* ss_row; const float* ss_mid; float* ss_out;
    __device__ __forceinline__ void midk(f32x4 (&acc)[2][2][4][2], const Unit& u, int wr, int fr) const {
        int rb = u.pm * BM + wr * 64 + fr; asm volatile("" : "+v"(rb));
#pragma unroll
        for (int ai = 0; ai < 2; ++ai)
#pragma unroll
            for (int m = 0; m < 4; ++m) { const int row = rb + ai * HALF + m * 16;
                const float f = sqrtf((ss_row[row] * (1.f / 512.f) + K_EPS) / (ss_mid[row] * (1.f / 512.f) + K_EPS));
#pragma unroll
                for (int bj = 0; bj < 2; ++bj)
#pragma unroll
                    for (int n = 0; n < 2; ++n) acc[ai][bj][m][n] *= f;
                asm volatile("" ::: "memory"); }
    }
    __device__ __forceinline__ void operator()(const f32x4 (&acc)[2][2][4][2], const Unit& u, int wr, int wc, int fr, int fq) const {
        const int col0 = u.pn * BM + wc * 32 + 8 * fq;
#pragma unroll
        for (int ai = 0; ai < 2; ++ai)
#pragma unroll
            for (int m = 0; m < 4; ++m) { const int row = u.pm * BM + wr * 64 + fr + ai * HALF + m * 16; const size_t off = (size_t)row * 1024 + col0;
                const float rsc = scale * (ss_row ? rsqrtf(ss_row[row] * (1.f / 512.f) + K_EPS) : 1.f); float sq = 0.f;
#pragma unroll
                for (int bj = 0; bj < 2; ++bj) { f32x4 x0, x1;
                    if (XRES_BF16) { const u32x4 r = *(const u32x4*)((const bf16_t*)xres + off + bj * HALF);
                        x0 = (f32x4){__uint_as_float(r.x << 16), __uint_as_float(r.x & 0xffff0000u), __uint_as_float(r.y << 16), __uint_as_float(r.y & 0xffff0000u)};
                        x1 = (f32x4){__uint_as_float(r.z << 16), __uint_as_float(r.z & 0xffff0000u), __uint_as_float(r.w << 16), __uint_as_float(r.w & 0xffff0000u)}; }
                    else { x0 = __builtin_nontemporal_load((const f32x4*)((const float*)xres + off + bj * HALF)); x1 = __builtin_nontemporal_load((const f32x4*)((const float*)xres + off + bj * HALF + 4)); }
                    const f32x4 o0 = x0 + acc[ai][bj][m][0] * rsc, o1 = x1 + acc[ai][bj][m][1] * rsc;
                    if (OUT_BF16) st16((bf16_t*)out + off + bj * HALF, pack8(o0, o1));
                    else { __builtin_nontemporal_store(o0, (f32x4*)((float*)out + off + bj * HALF)); __builtin_nontemporal_store(o1, (f32x4*)((float*)out + off + bj * HALF + 4)); }
                    if (ss_out) sq += sumsq4(o0) + sumsq4(o1); }
                if (ss_out) { sq += __shfl_xor(sq, 16); sq += __shfl_xor(sq, 32); if (fq == 0) atomicAdd(ss_out + row, sq); } }
    }
};

struct EpiMix {
    static constexpr bool PERM = true, AFTER_DRAIN = false; static constexpr int MIDK = 0;
    const float* ss2; const float* g_q; const float* g_k; bf16_t* QB; float* ssv;
    __device__ __forceinline__ void midk(f32x4 (&)[2][2][4][2], const Unit&, int, int) const {}
    __device__ __forceinline__ void operator()(const f32x4 (&acc)[2][2][4][2], const Unit& u, int wr, int wc, int fr, int fq) const {
        const int pn = unit_pn(u), rowl = wr * 64 + fr; const int hoff = unit_hm(u) > 0 ? HALF : 0, nai = unit_hm(u) < 0 ? 2 : 1;
        if (pn < 4) {
            const float* g = pn < 2 ? g_q : g_k; bf16_t* dst = QB + (size_t)(pn >> 1) * (8u << 20); const float sc = pn < 2 ? K_C2 : 1.f; const int cb = (pn & 1) * 256 + 64 * wc + 8 * fq;
            f32x4 gv[2][2];
#pragma unroll
            for (int bj = 0; bj < 2; ++bj)
#pragma unroll
                for (int n = 0; n < 2; ++n) gv[bj][n] = *(const f32x4*)(g + 32 * bj + 8 * fq + 4 * n) * sc;
#pragma unroll
            for (int ai = 0; ai < 2; ++ai) if (ai < nai)
#pragma unroll
                for (int m = 0; m < 4; ++m) { const int row = u.pm * BM + hoff + rowl + ai * HALF + m * 16; const float rs2 = rsqrtf(ss2[row] * (1.f / 1024.f) + K_EPS);
                    f32x4 v[2][2]; float s = 0.f;
#pragma unroll
                    for (int bj = 0; bj < 2; ++bj)
#pragma unroll
                        for (int n = 0; n < 2; ++n) { v[bj][n] = acc[ai][bj][m][n] * rs2; s += sumsq4(v[bj][n]); }
                    s += __shfl_xor(s, 16); s += __shfl_xor(s, 32);
                    const float rh = rsqrtf(s * (1.f / 64.f) + K_EPS);
#pragma unroll
                    for (int bj = 0; bj < 2; ++bj) st16(dst + (size_t)row * 512 + cb + 32 * bj, pack8(v[bj][0] * rh * gv[bj][0], v[bj][1] * rh * gv[bj][1])); }
        } else {
            const int grp = (pn - 4) >> 1; bf16_t* dst = QB + (size_t)(pn >> 1) * (8u << 20); const int cb = ((pn - 4) & 1) * 256 + wc * 32 + 8 * fq;
#pragma unroll
            for (int ai = 0; ai < 2; ++ai) if (ai < nai)
#pragma unroll
                for (int m = 0; m < 4; ++m) { const int row = u.pm * BM + hoff + rowl + ai * HALF + m * 16; const float rs2 = rsqrtf(ss2[row] * (1.f / 1024.f) + K_EPS); float sq = 0.f;
#pragma unroll
                    for (int bj = 0; bj < 2; ++bj) { f32x4 v0 = acc[ai][bj][m][0] * rs2, v1 = acc[ai][bj][m][1] * rs2;
                        if (grp) {
#pragma unroll
                            for (int e = 0; e < 4; ++e) { v0[e] = gelu_tanh_f(v0[e]); v1[e] = gelu_tanh_f(v1[e]); } }
                        if (grp == 2) sq += sumsq4(v0) + sumsq4(v1);
                        st16(dst + (size_t)row * 512 + cb + bj * HALF, pack8(v0, v1)); }
                    if (grp == 2 && ssv) { sq += __shfl_xor(sq, 16); sq += __shfl_xor(sq, 32); if (fq == 0) atomicAdd(ssv + row, sq); } }
        }
    }
};

struct EpiCQ {
    static constexpr bool PERM = true, AFTER_DRAIN = true; static constexpr int MIDK = 0;
    const float* ss3; const float* g_cq; bf16_t* QC;
    __device__ __forceinline__ void midk(f32x4 (&)[2][2][4][2], const Unit&, int, int) const {}
    __device__ __forceinline__ void fused(f32x4 (&acc)[2][2][4][2], const Unit& u, int wr, int wc, int fr, int fq, PG8_LAS unsigned char* lds, int wid, int lane) const {
        PG8_LAS float* P = (PG8_LAS float*)lds;
#pragma unroll
        for (int ai = 0; ai < 2; ++ai)
#pragma unroll
            for (int m = 0; m < 4; ++m) { const int rowl = ai * HALF + wr * 64 + m * 16 + fr; const float r3 = rsqrtf(ss3[u.pm * BM + rowl] * (1.f / 1024.f) + K_EPS); float s = 0.f;
#pragma unroll
                for (int bj = 0; bj < 2; ++bj)
#pragma unroll
                    for (int n = 0; n < 2; ++n) { acc[ai][bj][m][n] *= r3; s += sumsq4(acc[ai][bj][m][n]); }
                s += __shfl_xor(s, 16); s += __shfl_xor(s, 32);
                if (fq == 0) P[rowl * 4 + wc] = s; }
        asm volatile("s_waitcnt lgkmcnt(0)" ::: "memory"); __builtin_amdgcn_s_barrier(); asm volatile("" ::: "memory");
        f32x4 gv[2][2];
#pragma unroll
        for (int bj = 0; bj < 2; ++bj)
#pragma unroll
            for (int n = 0; n < 2; ++n) gv[bj][n] = *(const f32x4*)(g_cq + bj * HALF + wc * 32 + 8 * fq + 4 * n) * K_C2C;
#pragma unroll
        for (int ai = 0; ai < 2; ++ai)
#pragma unroll
            for (int m = 0; m < 4; ++m) { const int rowl = ai * HALF + wr * 64 + m * 16 + fr; const f32x4 t = *(const PG8_LAS f32x4*)(P + rowl * 4);
                const float rh = rsqrtf(((t[0] + t[1]) + (t[2] + t[3])) * (1.f / 256.f) + K_EPS); bf16_t* rowp = QC + (size_t)(u.pm * BM + rowl) * 1024 + u.pn * BM + wc * 32 + 8 * fq;
#pragma unroll
                for (int bj = 0; bj < 2; ++bj) st16(rowp + bj * HALF, pack8(acc[ai][bj][m][0] * rh * gv[bj][0], acc[ai][bj][m][1] * rh * gv[bj][1])); }
    }
};
template <class Epi, class Sched, bool ALIGN_EPI = false, bool SP2 = false, bool HALFU = false>
__device__ __forceinline__ void gemm_phase(PG8_LAS unsigned char* lds, const Gemm g, const Sched& S, const Epi& E) {
    const int tid = threadIdx.x, wid = __builtin_amdgcn_readfirstlane(tid >> 6), lane = tid & 63, wr = wid >> 2, wc = wid & 3, fr = lane & 15, fq = lane >> 4;
    const int K = g.K, nt = K / BK;
    unsigned voffA[2], voffB[2];
#pragma unroll
    for (int i = 0; i < 2; ++i) { int R, C; stage_rc(tid * 16 + i * 8192, R, C); const int Rb = Epi::PERM ? ((R & ~31) + perm32(R & 31)) : R;
        voffA[i] = (unsigned)(R * K + C) * 2u; voffB[i] = (unsigned)(Rb * K + C) * 2u; }
    const size_t kstep = (size_t)(BK * 2);
    const size_t hstep = (size_t)HALF * K * 2;
    const size_t tstep = 2 * hstep;
    const unsigned ldsw = (unsigned)wid * 1024u;
    const int aoff = lds_byte(wr * 64 + fr, fq * 8), boff = lds_byte(wc * 32 + fr, fq * 8);
#define PG8_SA(b, h) (((b) * 2 + (h)) * HTB)
#define PG8_SB(b, h) ((4 + (b) * 2 + (h)) * HTB)
#define PG8_STAGE(bufoff, gbase, voff) do { _Pragma("unroll") for (int _i = 0; _i < 2; ++_i) \
        __builtin_amdgcn_global_load_lds((const unsigned*)((const char*)(gbase) + (voff)[_i]), (PG8_LAS unsigned*)(lds + (bufoff) + ldsw + _i * 8192), 16, 0, 0); } while (0)
#define PG8_LDA(dst, b, h) do { _Pragma("unroll") for (int m = 0; m < 4; ++m) _Pragma("unroll") for (int k = 0; k < 2; ++k) dst[m][k] = *(const PG8_LAS bf16x8*)(lds + PG8_SA(b, h) + aoff + m * 2048 + k * 1024); } while (0)
#define PG8_LDB(dst, b, h) do { _Pragma("unroll") for (int n = 0; n < 2; ++n) _Pragma("unroll") for (int k = 0; k < 2; ++k) dst[n][k] = *(const PG8_LAS bf16x8*)(lds + PG8_SB(b, h) + boff + n * 2048 + k * 1024); } while (0)
#define PG8_MMA(ai, bj, At, Bt) do { __builtin_amdgcn_s_setprio(1); _Pragma("unroll") for (int m = 0; m < 4; ++m) _Pragma("unroll") for (int n = 0; n < 2; ++n) _Pragma("unroll") for (int k = 0; k < 2; ++k) \
        acc[ai][bj][m][n] = __builtin_amdgcn_mfma_f32_16x16x32_bf16(Bt[n][k], At[m][k], acc[ai][bj][m][n], 0, 0, 0); __builtin_amdgcn_s_setprio(0); } while (0)
#define PG8_WAIT_V(n) asm volatile("s_waitcnt vmcnt(" #n ")" ::: "memory")
#define PG8_WAIT_L(n) asm volatile("s_waitcnt lgkmcnt(" #n ")" ::: "memory")
#define PG8_BAR __builtin_amdgcn_s_barrier()
#define PG8_SCHED __builtin_amdgcn_sched_barrier(0)
    Unit cur, nxt; int ui = 0;
    if (!S.next(0, cur)) return;
    f32x4 acc[2][2][4][2];
#pragma unroll
    for (int a = 0; a < 2; ++a)
#pragma unroll
        for (int b = 0; b < 2; ++b)
#pragma unroll
            for (int m = 0; m < 4; ++m)
#pragma unroll
                for (int n = 0; n < 2; ++n) acc[a][b][m][n] = (f32x4){0.f, 0.f, 0.f, 0.f};
    bf16x8 At[4][2], B0[2][2], B1[2][2];
    const char* cA = (const char*)g.A + (size_t)cur.pm * tstep + (unit_hm(cur) > 0 ? hstep : (size_t)0); const char* cB = (const char*)g.Bt + (size_t)unit_pn(cur) * tstep;
    bool full = unit_hm(cur) < 0;
    S.a_ready(cur);
    if constexpr (SP2) {
        PG8_STAGE(PG8_SB(0, 0), cB, voffB); PG8_STAGE(PG8_SB(0, 1), cB + hstep, voffB); PG8_STAGE(PG8_SA(0, 0), cA, voffA); PG8_STAGE(PG8_SA(0, 1), cA + hstep, voffA);
        if (wr == 1) PG8_BAR;
        PG8_WAIT_V(2); PG8_BAR;
        PG8_STAGE(PG8_SB(1, 0), cB + kstep, voffB); PG8_STAGE(PG8_SA(1, 0), cA + kstep, voffA); PG8_STAGE(PG8_SB(1, 1), cB + hstep + kstep, voffB);
        PG8_WAIT_V(6); PG8_BAR;
    } else {
        PG8_STAGE(PG8_SB(0, 0), cB, voffB); PG8_STAGE(PG8_SA(0, 0), cA, voffA); PG8_STAGE(PG8_SB(0, 1), cB + hstep, voffB); PG8_STAGE(PG8_SA(0, 1), cA + hstep, voffA);
        if (wr == 1) PG8_BAR;
        PG8_WAIT_V(4); PG8_BAR;
        PG8_STAGE(PG8_SB(1, 0), cB + kstep, voffB); PG8_STAGE(PG8_SA(1, 0), cA + kstep, voffA); PG8_STAGE(PG8_SB(1, 1), cB + hstep + kstep, voffB);
        PG8_WAIT_V(6); PG8_BAR;
    }
    for (;;) {
        const bool has_next = S.next(ui + 1, nxt);
        const char* nA = has_next ? (const char*)g.A + (size_t)nxt.pm * tstep + (unit_hm(nxt) > 0 ? hstep : (size_t)0) : cA; const char* nB = has_next ? (const char*)g.Bt + (size_t)unit_pn(nxt) * tstep : cB;
        for (int t = 0; t < nt; t += 2) {
            if constexpr (Epi::MIDK > 0) { if (t == Epi::MIDK) E.midk(acc, cur, wr, fr); }
            const bool last = (t == nt - 2);
            const char* a1 = cA + (size_t)(t + 1) * kstep;
            const char* a2 = last ? nA : cA + (size_t)(t + 2) * kstep; const char* b2 = last ? nB : cB + (size_t)(t + 2) * kstep;
            const char* a3 = a2 + kstep; const char* b3 = b2 + kstep;
            if (last && has_next) S.a_ready(nxt);
            if constexpr (SP2) {
            PG8_LDB(B0, 0, 0); PG8_LDB(B1, 0, 1); PG8_SCHED; PG8_LDA(At, 0, 0); PG8_STAGE(PG8_SA(1, 1), a1 + hstep, voffA);
            PG8_WAIT_V(8); PG8_WAIT_L(0); PG8_BAR; PG8_MMA(0, 0, At, B0); PG8_MMA(0, 1, At, B1); PG8_BAR; PG8_SCHED;
            PG8_LDA(At, 0, 1); PG8_STAGE(PG8_SB(0, 0), b2, voffB); PG8_STAGE(PG8_SB(0, 1), b2 + hstep, voffB); PG8_STAGE(PG8_SA(0, 0), a2, voffA);
            PG8_WAIT_V(8); PG8_WAIT_L(0); PG8_BAR; if (!HALFU || full) { PG8_MMA(1, 0, At, B0); PG8_MMA(1, 1, At, B1); } PG8_BAR; PG8_SCHED;
            PG8_LDB(B0, 1, 0); PG8_LDB(B1, 1, 1); PG8_SCHED; PG8_LDA(At, 1, 0); PG8_STAGE(PG8_SA(0, 1), a2 + hstep, voffA);
            PG8_WAIT_V(8); PG8_WAIT_L(0); PG8_BAR; PG8_MMA(0, 0, At, B0); PG8_MMA(0, 1, At, B1); PG8_BAR; PG8_SCHED;
            PG8_LDA(At, 1, 1); PG8_STAGE(PG8_SB(1, 0), b3, voffB); PG8_STAGE(PG8_SB(1, 1), b3 + hstep, voffB); PG8_STAGE(PG8_SA(1, 0), a3, voffA);
            PG8_WAIT_V(8); PG8_WAIT_L(0); PG8_BAR; if (!HALFU || full) { PG8_MMA(1, 0, At, B0); PG8_MMA(1, 1, At, B1); } PG8_BAR; PG8_SCHED;
            } else {
            PG8_LDB(B0, 0, 0); PG8_SCHED; PG8_LDA(At, 0, 0); PG8_STAGE(PG8_SA(1, 1), a1 + hstep, voffA);
            PG8_WAIT_L(8); PG8_BAR; PG8_WAIT_L(0); PG8_MMA(0, 0, At, B0); PG8_BAR; PG8_SCHED;
            PG8_LDB(B1, 0, 1); PG8_STAGE(PG8_SB(0, 0), b2, voffB);
            PG8_BAR; PG8_WAIT_L(0); PG8_MMA(0, 1, At, B1); PG8_BAR;
            PG8_LDA(At, 0, 1); PG8_STAGE(PG8_SA(0, 0), a2, voffA);
            PG8_BAR; PG8_WAIT_L(0); PG8_MMA(1, 0, At, B0); PG8_BAR; PG8_SCHED;
            PG8_STAGE(PG8_SB(0, 1), b2 + hstep, voffB);
            PG8_WAIT_V(6); PG8_BAR; PG8_MMA(1, 1, At, B1); PG8_BAR;
            PG8_LDB(B0, 1, 0); PG8_SCHED; PG8_LDA(At, 1, 0); PG8_STAGE(PG8_SA(0, 1), a2 + hstep, voffA);
            PG8_WAIT_L(8); PG8_BAR; PG8_WAIT_L(0); PG8_MMA(0, 0, At, B0); PG8_BAR; PG8_SCHED;
            PG8_LDB(B1, 1, 1); PG8_STAGE(PG8_SB(1, 0), b3, voffB);
            PG8_BAR; PG8_WAIT_L(0); PG8_MMA(0, 1, At, B1); PG8_BAR;
            PG8_LDA(At, 1, 1); PG8_STAGE(PG8_SA(1, 0), a3, voffA);
            PG8_BAR; PG8_WAIT_L(0); PG8_MMA(1, 0, At, B0); PG8_BAR; PG8_SCHED;
            PG8_STAGE(PG8_SB(1, 1), b3 + hstep, voffB);
            PG8_WAIT_V(6); PG8_BAR; PG8_MMA(1, 1, At, B1); PG8_BAR;
            }
        }
        if constexpr (ALIGN_EPI) { if (wr == 0) PG8_BAR; }
        if constexpr (!Epi::AFTER_DRAIN) { E(acc, cur, wr, wc, fr, fq); S.done(cur); }
        if (!has_next) break;
#pragma unroll
        for (int a = 0; a < 2; ++a)
#pragma unroll
            for (int b = 0; b < 2; ++b)
#pragma unroll
                for (int m = 0; m < 4; ++m)
#pragma unroll
                    for (int n = 0; n < 2; ++n) acc[a][b][m][n] = (f32x4){0.f, 0.f, 0.f, 0.f};
        cur = nxt; cA = nA; cB = nB; ++ui; full = unit_hm(cur) < 0;
        if constexpr (ALIGN_EPI) { if (wr == 1) PG8_BAR; }
    }
    PG8_WAIT_V(0);
    if constexpr (!ALIGN_EPI) { if (wr == 0) PG8_BAR; }
    PG8_BAR;
    if constexpr (Epi::AFTER_DRAIN) { E.fused(acc, cur, wr, wc, fr, fq, lds, wid, lane); S.done(cur); }
#undef PG8_SA
#undef PG8_SB
#undef PG8_STAGE
#undef PG8_LDA
#undef PG8_LDB
#undef PG8_MMA
#undef PG8_WAIT_V
#undef PG8_WAIT_L
#undef PG8_BAR
#undef PG8_SCHED
}
}
#ifndef PG8_SP2
#define PG8_SP2 true
#endif
#ifndef PG8_ALIGN
#define PG8_ALIGN true
#endif
namespace attn_body {
using bf16=__hip_bfloat16;
using bf16x8=__attribute__((ext_vector_type(8)))short;
using s16x4=__attribute__((ext_vector_type(4)))short;
using f32x16=__attribute__((ext_vector_type(16)))float;
using u32x4=__attribute__((ext_vector_type(4)))unsigned;
constexpr int BATCH=4,NHEAD=8,SEQ=4096,D=64,DM=NHEAD*D;
constexpr int NW=8,QBLK=32,QB=QBLK*NW,KVBLK=64,NQB=SEQ/QB;
constexpr int ATTN_PITCH=DM, ATTN_UNIT_ROWS=QB;
__device__ __forceinline__ int crow(int r,int hi){return (r&3)+8*(r>>2)+4*hi;}
#define SBAR() __builtin_amdgcn_sched_barrier(0)
__device__ __forceinline__ void cmask(f32x16&p0,f32x16&p1,int jb,int qrel,int hi){
  const float NEG=-INFINITY; int kb=64*jb+4*hi;
  #pragma unroll
  for(int r=0;r<16;++r){int kv=kb+(r&3)+8*(r>>2); if(kv>qrel)p0[r]=NEG; if(kv+32>qrel)p1[r]=NEG;}
}

constexpr int NSLOT=3, SLOTB=8192;
constexpr int LDS_K=0, LDS_V=NSLOT*SLOTB, LDS_WS=2*NSLOT*SLOTB, LDS_OST=LDS_WS+NW*64*4, LDS_C=LDS_OST+NW*4096, LDS_SCAN=LDS_C+SEQ*4, LDS_BYTES=LDS_SCAN+64;
constexpr float C2=0.125f*1.4426950408889634f;
__device__ __forceinline__ void glds16(const void*gsrc,unsigned lds_dst){unsigned keep;
  asm volatile("s_mov_b32 %0, m0\n\ts_mov_b32 m0, %2\n\ts_nop 0\n\tglobal_load_lds_dwordx4 %1, off\n\ts_mov_b32 m0, %0":"=&s"(keep):"v"(gsrc),"s"(lds_dst):"memory");}
__device__ __forceinline__ float max3f(float a,float b,float c){float r;asm("v_max3_f32 %0, %1, %2, %3":"=v"(r):"v"(a),"v"(b),"v"(c));return r;}
__device__ __forceinline__ float max2f(float a,float b){float r;asm("v_max_f32_e32 %0, %1, %2":"=v"(r):"v"(a),"v"(b));return r;}
__device__ __forceinline__ float fadd_s(float a,float b){float r;asm("v_add_f32_e32 %0, %1, %2":"=v"(r):"v"(a),"v"(b));return r;}
__device__ __forceinline__ float fsub_s(float a,float b){float r;asm("v_sub_f32_e32 %0, %1, %2":"=v"(r):"v"(a),"v"(b));return r;}
typedef float f32x2_t __attribute__((ext_vector_type(2))); typedef __bf16 bf16x2_t __attribute__((ext_vector_type(2)));
__device__ __forceinline__ unsigned cvtpk_s(float lo,float hi){f32x2_t v={lo,hi};bf16x2_t b=__builtin_convertvector(v,bf16x2_t);return __builtin_bit_cast(unsigned,b);}
#define WAIT_BAR(N) asm volatile("s_waitcnt vmcnt(" #N ") lgkmcnt(0)\n\ts_barrier":::"memory")

__device__ __forceinline__ void qkt(f32x16&p0,f32x16&p1,const char*Kslot,const bf16x8*qr,int r32,int hi){
  const char*kb=Kslot+hi*1024+r32*16;
  #pragma unroll
  for(int d0=0;d0<4;++d0){
    const bf16x8 b0=*reinterpret_cast<const bf16x8*>(kb+d0*2048);
    const bf16x8 b1=*reinterpret_cast<const bf16x8*>(kb+d0*2048+512);
    p0=__builtin_amdgcn_mfma_f32_32x32x16_bf16(b0,qr[d0],p0,0,0,0);p1=__builtin_amdgcn_mfma_f32_32x32x16_bf16(b1,qr[d0],p1,0,0,0);}
}
typedef __attribute__((address_space(3))) const char* lds_cptr;
typedef short v4i16_t __attribute__((ext_vector_type(4)));
__device__ __forceinline__ void kload8(bf16x8*kf,lds_cptr kp){
  kf[0]=*(const __attribute__((address_space(3))) bf16x8*)(kp);      kf[1]=*(const __attribute__((address_space(3))) bf16x8*)(kp+512);
  kf[2]=*(const __attribute__((address_space(3))) bf16x8*)(kp+2048); kf[3]=*(const __attribute__((address_space(3))) bf16x8*)(kp+2560);
  kf[4]=*(const __attribute__((address_space(3))) bf16x8*)(kp+4096); kf[5]=*(const __attribute__((address_space(3))) bf16x8*)(kp+4608);
  kf[6]=*(const __attribute__((address_space(3))) bf16x8*)(kp+6144); kf[7]=*(const __attribute__((address_space(3))) bf16x8*)(kp+6656);
}
__device__ __forceinline__ void kload2(bf16x8*kf,lds_cptr kp,int j){ kf[2*j]=*(const __attribute__((address_space(3))) bf16x8*)(kp+j*2048); kf[2*j+1]=*(const __attribute__((address_space(3))) bf16x8*)(kp+j*2048+512); }
__device__ __forceinline__ s16x4 vtr(lds_cptr p){ return __builtin_bit_cast(s16x4,__builtin_amdgcn_ds_read_tr16_b64_v4i16((__attribute__((address_space(3))) v4i16_t*)p)); }
__device__ __forceinline__ float rowmax(const f32x16&p0,const f32x16&p1){
  float a=max3f(p0[0],p0[1],p1[0]),b=max3f(p0[2],p0[3],p1[1]);a=max3f(a,p1[2],p1[3]);
  #pragma unroll
  for(int r=4;r<16;r+=4){a=max3f(a,p0[r],p0[r+1]);b=max3f(b,p0[r+2],p0[r+3]);a=max3f(a,p1[r],p1[r+1]);b=max3f(b,p1[r+2],p1[r+3]);}
  const float m=max2f(a,b);
  auto rr=__builtin_amdgcn_permlane32_swap(__float_as_uint(m),__float_as_uint(m),false,false);
  return max2f(__uint_as_float(rr[0]),__uint_as_float(rr[1]));
}
__device__ __forceinline__ void pv(f32x16*o,int vb,bf16x8 pa0,bf16x8 pa1,bf16x8 pa2,bf16x8 pa3){
  #pragma unroll
  for(int d0=0;d0<2;++d0){s16x4 lo[4],hi[4];
    #pragma unroll
    for(int ks=0;ks<4;++ks){
      asm volatile("ds_read_b64_tr_b16 %0,%1 offset:%c2":"=&v"(lo[ks]):"v"(vb),"i"(d0*4096+ks*1024):"memory");
      asm volatile("ds_read_b64_tr_b16 %0,%1 offset:%c2":"=&v"(hi[ks]):"v"(vb),"i"(d0*4096+ks*1024+512):"memory");}
    asm volatile("s_waitcnt lgkmcnt(0)":::"memory");SBAR();
    #define PK(k) (bf16x8){lo[k][0],lo[k][1],lo[k][2],lo[k][3],hi[k][0],hi[k][1],hi[k][2],hi[k][3]}
    o[d0]=__builtin_amdgcn_mfma_f32_32x32x16_bf16(pa0,PK(0),o[d0],0,0,0);
    o[d0]=__builtin_amdgcn_mfma_f32_32x32x16_bf16(pa1,PK(1),o[d0],0,0,0);
    o[d0]=__builtin_amdgcn_mfma_f32_32x32x16_bf16(pa2,PK(2),o[d0],0,0,0);
    o[d0]=__builtin_amdgcn_mfma_f32_32x32x16_bf16(pa3,PK(3),o[d0],0,0,0);
    #undef PK
  }
}

#ifndef ATTN_STORE16
#define ATTN_STORE16(p,v) (*(u32x4*)(p)=(v))
#endif
template<int THRL> __device__ __forceinline__ void attn_unit(int b,int h,int qb,const bf16*Q,const bf16*__restrict__ K,const bf16*__restrict__ V,unsigned short*Y,const float*gfo,float*ssa,char*shm,int t0){
  int tid=threadIdx.x; asm volatile("":"+v"(tid)); const int lane=tid&63,r32=lane&31,hi=lane>>5; const int wid=__builtin_amdgcn_readfirstlane(tid>>6);
  const long rowbase=(long)b*SEQ; const int q0=qb*QB;
  const bf16*Qw=Q+(rowbase+q0+wid*QBLK)*DM+h*D;
  const bf16*Kh=K+(rowbase+(long)t0*KVBLK)*DM+h*D,*Vh=V+(rowbase+(long)t0*KVBLK)*DM+h*D;
  const unsigned lds0=(unsigned)(uintptr_t)shm;
  float*wsf=(float*)(shm+LDS_WS)+wid*64;
  const bf16*ksrc=Kh+(long)lane*DM+wid*8;
  const bf16*vsrc=Vh+(long)(16*(wid&3)+(lane>>2))*DM+(wid>>2)*32+(lane&3)*8;
  const unsigned kdst=lds0+LDS_K+wid*1024, vdst=lds0+LDS_V+wid*1024;
  #define DMA_K(t,slot) glds16(ksrc+(long)(t)*KVBLK*DM,(unsigned)__builtin_amdgcn_readfirstlane(kdst+(slot)))
  #define DMA_V(t,slot) glds16(vsrc+(long)(t)*KVBLK*DM,(unsigned)__builtin_amdgcn_readfirstlane(vdst+(slot)))
  const int vb0=(int)(lds0+LDS_V)+((lane>>4)&1)*32+(lane&3)*8+(4*hi+((lane&15)>>2))*64;
  const char*Kbase=shm+LDS_K; bf16x8 kf[8];
  const lds_cptr shm3=(lds_cptr)shm; const lds_cptr kp0=shm3+LDS_K+hi*1024+r32*16; const lds_cptr vp0=shm3+LDS_V+((lane>>4)&1)*32+(lane&3)*8+(4*hi+((lane&15)>>2))*64;
  const int NT=(q0+QB)/KVBLK-t0;
  DMA_K(0,0);DMA_V(0,0);DMA_K(1,SLOTB);
  bf16x8 qr[4];
  #pragma unroll
  for(int d0=0;d0<4;++d0)qr[d0]=*reinterpret_cast<const bf16x8*>(&Qw[(long)r32*DM+d0*16+hi*8]);
  float mhat=0.f,l_reg=0.f;f32x16 o[2];o[0]=f32x16{};o[1]=f32x16{};
  typedef float f32x4_t __attribute__((ext_vector_type(4)));
  const lds_cptr clb=(lds_cptr)shm+LDS_C+t0*256;
  mhat=-((const __attribute__((address_space(3))) float*)((lds_cptr)shm+LDS_C))[q0+wid*QBLK+r32];
  #define BIAS(C0,C1,t) do{ const float bs_=-mhat; const int hl_=(int)(__builtin_amdgcn_mbcnt_hi(~0u,__builtin_amdgcn_mbcnt_lo(~0u,0u))>>5); const __attribute__((address_space(3))) f32x4_t* cl4=(const __attribute__((address_space(3))) f32x4_t*)(clb+(t)*256)+hl_; \
      _Pragma("unroll") for(int j_=0;j_<4;++j_){ const f32x4_t a_=cl4[2*j_], b_=cl4[8+2*j_]; \
      _Pragma("unroll") for(int e_=0;e_<4;++e_){ C0[4*j_+e_]=bs_-a_[e_]; C1[4*j_+e_]=bs_-b_[e_]; } } }while(0)
  const int qrel=wid*QBLK+r32;
  #define CMASK(P0,P1,t) do{int jb_=(t)-(NT-4); if(jb_>=0)cmask(P0,P1,jb_,qrel,hi);}while(0)
  #define START(P0,P1) do{ _Pragma("unroll") for(int r=0;r<16;++r)P0[r]=__builtin_amdgcn_exp2f(P0[r]); }while(0)
  #define RESC() do{}while(0)
  f32x16 pA0,pA1,pB0,pB1;
  int sl_prev=0,sl_cur=0,sl_next=SLOTB;
  #define ROT() do{sl_prev=sl_cur;sl_cur=sl_next;sl_next=(sl_next==(NSLOT-1)*SLOTB)?0:sl_next+SLOTB;}while(0)
  DMA_K(2,2*SLOTB);
  WAIT_BAR(3);
  BIAS(pA0,pA1,0); qkt(pA0,pA1,Kbase,qr,r32,hi);asm volatile("s_nop 15\n\ts_nop 7":"+v"(pA0),"+v"(pA1));CMASK(pA0,pA1,0);
  START(pA0,pA1);
  _Pragma("unroll") for(int r=0;r<16;++r)pA1[r]=__builtin_amdgcn_exp2f(pA1[r]);
  WAIT_BAR(0);
  DMA_K(3,0);DMA_V(1,SLOTB);
  ROT();
  kload8(kf,kp0+sl_cur);
  WAIT_BAR(2);
  s16x4 vlo[8],vhi[8]; u32x4 pw0,pw1,pw2,pw3;
  #define PKW(P,B) cvtpk_s(P[B],P[B+1])
  #define PAF(k) __builtin_bit_cast(bf16x8,pw##k)
  #define VFR(i) (bf16x8){vlo[i][0],vlo[i][1],vlo[i][2],vlo[i][3],vhi[i][0],vhi[i][1],vhi[i][2],vhi[i][3]}
  #define PIN(x) asm volatile("":"+v"(x))
  #define MX3(a,b,c) __builtin_fmaxf(__builtin_fmaxf((a),(b)),(c))
  #define GAPA(MF,A0,A1,A2,A3,W0,W1,PW) do{ MF; sacc+=A0; sacc+=A1; sacc+=A2; sacc+=A3; PIN(sacc); W0; W1; PIN(PW); SBAR(); }while(0)
  #define EX(v) __builtin_amdgcn_exp2f(v)
  #define GAPB(MF,X,B) do{ MF; X[B]=EX(X[B]); X[B+1]=EX(X[B+1]); X[B+2]=EX(X[B+2]); X[B+3]=EX(X[B+3]); PIN(X); SBAR(); }while(0)
  #define VRD(i) do{ vlo[i]=vtr(vp_+(((i)>>2)*4096+((i)&3)*1024)); vhi[i]=vtr(vp_+(((i)>>2)*4096+((i)&3)*1024+512)); }while(0)
  #define KRD(G,j) do{ if(G){ kload2(kf,kp0+sl_next,j); SBAR(); } }while(0)
  #define STEP(C0,C1,P0,P1,t,GK,GV,GL) do{ BIAS(C0,C1,t); SBAR(); \
    const lds_cptr vp_=vp0+sl_prev; \
    VRD(0); SBAR(); float sacc=(P0[0]+P0[1]); \
    GAPA(C0=__builtin_amdgcn_mfma_f32_32x32x16_bf16(kf[0],qr[0],C0,0,0,0), P0[2],P0[3],P0[4],P0[5],     pw0[0]=PKW(P0,0), pw0[1]=PKW(P0,2), pw0); \
    VRD(4); SBAR(); GAPA(C1=__builtin_amdgcn_mfma_f32_32x32x16_bf16(kf[1],qr[0],C1,0,0,0), P0[6],P0[7],P0[8],P0[9],     pw0[2]=PKW(P0,4), pw0[3]=PKW(P0,6), pw0); \
    VRD(1); SBAR(); GAPA(C0=__builtin_amdgcn_mfma_f32_32x32x16_bf16(kf[2],qr[1],C0,0,0,0),   P0[10],P0[11],P0[12],P0[13], pw1[0]=PKW(P0,8), pw1[1]=PKW(P0,10), pw1); \
    VRD(5); SBAR(); GAPA(C1=__builtin_amdgcn_mfma_f32_32x32x16_bf16(kf[3],qr[1],C1,0,0,0),   P0[14],P0[15],P1[0],P1[1],   pw1[2]=PKW(P0,12),pw1[3]=PKW(P0,14), pw1); \
    VRD(2); SBAR(); GAPA(C0=__builtin_amdgcn_mfma_f32_32x32x16_bf16(kf[4],qr[2],C0,0,0,0),   P1[2],P1[3],P1[4],P1[5],     pw2[0]=PKW(P1,0), pw2[1]=PKW(P1,2), pw2); \
    VRD(6); SBAR(); GAPA(C1=__builtin_amdgcn_mfma_f32_32x32x16_bf16(kf[5],qr[2],C1,0,0,0),   P1[6],P1[7],P1[8],P1[9],     pw2[2]=PKW(P1,4), pw2[3]=PKW(P1,6), pw2); \
    VRD(3); SBAR(); GAPA(C0=__builtin_amdgcn_mfma_f32_32x32x16_bf16(kf[6],qr[3],C0,0,0,0),   P1[10],P1[11],P1[12],P1[13], pw3[0]=PKW(P1,8), pw3[1]=PKW(P1,10), pw3); \
    VRD(7); SBAR(); GAPA(C1=__builtin_amdgcn_mfma_f32_32x32x16_bf16(kf[7],qr[3],C1,0,0,0),   P1[14],P1[15],0.f,0.f,       pw3[2]=PKW(P1,12),pw3[3]=PKW(P1,14), pw3); \
    l_reg+=sacc; \
    if(GK){DMA_K((t)+3,sl_cur);} if(GV){DMA_V((t)+1,sl_next);} \
    CMASK(C0,C1,t); \
    SBAR(); \
    GAPB(o[0]=__builtin_amdgcn_mfma_f32_32x32x16_bf16(PAF(0),VFR(0),o[0],0,0,0), C0,0); \
    GAPB(o[1]=__builtin_amdgcn_mfma_f32_32x32x16_bf16(PAF(0),VFR(4),o[1],0,0,0), C0,4); \
    KRD(GL,0); GAPB(o[0]=__builtin_amdgcn_mfma_f32_32x32x16_bf16(PAF(1),VFR(1),o[0],0,0,0), C0,8); \
    KRD(GL,1); GAPB(o[1]=__builtin_amdgcn_mfma_f32_32x32x16_bf16(PAF(1),VFR(5),o[1],0,0,0), C0,12); \
    KRD(GL,2); GAPB(o[0]=__builtin_amdgcn_mfma_f32_32x32x16_bf16(PAF(2),VFR(2),o[0],0,0,0), C1,0); \
    KRD(GL,3); GAPB(o[1]=__builtin_amdgcn_mfma_f32_32x32x16_bf16(PAF(2),VFR(6),o[1],0,0,0), C1,4); \
    GAPB(o[0]=__builtin_amdgcn_mfma_f32_32x32x16_bf16(PAF(3),VFR(3),o[0],0,0,0), C1,8); \
    GAPB(o[1]=__builtin_amdgcn_mfma_f32_32x32x16_bf16(PAF(3),VFR(7),o[1],0,0,0), C1,12); \
    }while(0)
  int t=1;
  #undef CMASK
  #define CMASK(P0,P1,t) do{}while(0)
  for(;t+5<NT;t+=2){
    STEP(pB0,pB1,pA0,pA1,t,true,true,true);     WAIT_BAR(2); RESC(); ROT();
    STEP(pA0,pA1,pB0,pB1,t+1,true,true,true);   WAIT_BAR(2); RESC(); ROT();
  }
  #undef CMASK
  #define CMASK(P0,P1,t) do{int jb_=(t)-(NT-4); if(jb_>=0)cmask(P0,P1,jb_,qrel,hi);}while(0)
  #define ENDW(tt) do{ if((tt)+3<NT){WAIT_BAR(2);} else if((tt)+2<NT){WAIT_BAR(1);} else {WAIT_BAR(0);} }while(0)
  for(;t+1<NT;t+=2){
    STEP(pB0,pB1,pA0,pA1,t,(t+3<NT),(t+1<NT),(t+1<NT));       ENDW(t);   RESC(); ROT();
    STEP(pA0,pA1,pB0,pB1,t+1,(t+4<NT),(t+2<NT),(t+2<NT));     ENDW(t+1); RESC(); ROT();
  }
  STEP(pB0,pB1,pA0,pA1,NT-1,false,false,false); RESC();
  { float sacc=pB0[0]+pB0[1]; _Pragma("unroll") for(int r=2;r<16;++r)sacc+=pB0[r]; _Pragma("unroll") for(int r=0;r<16;++r)sacc+=pB1[r]; l_reg+=sacc;
    pw0=(u32x4){PKW(pB0,0),PKW(pB0,2),PKW(pB0,4),PKW(pB0,6)};pw1=(u32x4){PKW(pB0,8),PKW(pB0,10),PKW(pB0,12),PKW(pB0,14)};pw2=(u32x4){PKW(pB1,0),PKW(pB1,2),PKW(pB1,4),PKW(pB1,6)};pw3=(u32x4){PKW(pB1,8),PKW(pB1,10),PKW(pB1,12),PKW(pB1,14)};
    SBAR(); pv(o,vb0+sl_cur,PAF(0),PAF(1),PAF(2),PAF(3)); }
  #undef PKW
  #undef PAF
  #undef VFR
  #undef PIN
  #undef MX3
  #undef GAPA
  #undef GAPB
  #undef EX
  #undef VRD
  #undef KRD
  #undef STEP
  #undef ENDW
  {auto rr=__builtin_amdgcn_permlane32_swap(__float_as_uint(l_reg),__float_as_uint(l_reg),false,false);l_reg=__uint_as_float(rr[0])+__uint_as_float(rr[1]);}
  if(hi==0)wsf[32+r32]=l_reg;asm volatile("s_waitcnt lgkmcnt(0)":::"memory");
  float rli[16];
  #pragma unroll
  for(int r=0;r<16;++r)rli[r]=__builtin_amdgcn_rcpf(wsf[32+crow(r,hi)]);
  unsigned short*Ow=Y+(rowbase+q0+wid*QBLK)*1024+h*D; float*ssw=ssa+(rowbase+q0+wid*QBLK);
  { bf16*stg=(bf16*)(shm+LDS_OST)+wid*2048;
    #pragma unroll
    for(int r=0;r<16;++r){const int orow=crow(r,hi);
      #pragma unroll
      for(int d0=0;d0<2;++d0)stg[orow*64+d0*32+r32]=__float2bfloat16(o[d0][r]*rli[r]);}
    asm volatile("s_waitcnt lgkmcnt(0)":::"memory");
    #pragma unroll
    for(int i=0;i<4;++i){const int row=i*8+(lane>>3),ch=lane&7; const u32x4 v=*(const u32x4*)(stg+row*64+ch*8);
      const f32x4_t g0=*(const f32x4_t*)(gfo+h*D+ch*8), g1=*(const f32x4_t*)(gfo+h*D+ch*8+4); float sq=0.f; u32x4 w;
      { const float a0=__uint_as_float(v[0]<<16),a1=__uint_as_float(v[0]&0xffff0000u),a2=__uint_as_float(v[1]<<16),a3=__uint_as_float(v[1]&0xffff0000u); sq+=(a0*a0+a1*a1)+(a2*a2+a3*a3); w[0]=cvtpk_s(a0*g0[0],a1*g0[1]); w[1]=cvtpk_s(a2*g0[2],a3*g0[3]); }
      { const float a0=__uint_as_float(v[2]<<16),a1=__uint_as_float(v[2]&0xffff0000u),a2=__uint_as_float(v[3]<<16),a3=__uint_as_float(v[3]&0xffff0000u); sq+=(a0*a0+a1*a1)+(a2*a2+a3*a3); w[2]=cvtpk_s(a0*g1[0],a1*g1[1]); w[3]=cvtpk_s(a2*g1[2],a3*g1[3]); }
      sq+=__shfl_xor(sq,1); sq+=__shfl_xor(sq,2); sq+=__shfl_xor(sq,4); if(ch==0&&ssa)atomicAdd(ssw+row,sq);
      *(u32x4*)(Ow+(long)row*1024+ch*8)=w;} }
  asm volatile("s_waitcnt lgkmcnt(0)\n\ts_barrier":::"memory");
  #undef DMA_K
  #undef DMA_V
  #undef CMASK
  #undef START
  #undef RESC
  #undef ROT
  #undef BIAS
}
constexpr int ATTN_LDS_BYTES=LDS_BYTES;
struct AttnTensors { const bf16* Q; const bf16* K; const bf16* V; unsigned short* Y; const float* gfo; float* ssa; const float* logf; const float* gq; const float* gk; unsigned* queue; };
struct AttnUnit { int bh; int qb; };
struct StaticOrder {
  int vcu;
  __device__ __forceinline__ explicit StaticOrder(int grid,int block):vcu((block%8)*(grid/8)+block/8){}
  __device__ __forceinline__ bool next(int i,AttnUnit&u)const{ if(i>=2)return false; const int s=vcu&7; u.bh=vcu>>3; u.qb=(i==0)?s:15-s; return true; }
  __device__ __forceinline__ void a_ready(const AttnUnit&)const{}
  __device__ __forceinline__ void done(const AttnUnit&)const{}
};
template<class Sched,int THRL=40> __device__ __forceinline__ void attn_phase(char*lds,const AttnTensors&T,const Sched&){
  typedef float f32x4_t __attribute__((ext_vector_type(4)));
  float*scan=(float*)(lds+LDS_SCAN);
  float B2;
  { const int lane=threadIdx.x&63; float a=fabsf(T.gq[lane]),b=fabsf(T.gk[lane]);
    _Pragma("unroll") for(int o=1;o<64;o<<=1){ a=fmaxf(a,__shfl_xor(a,o)); b=fmaxf(b,__shfl_xor(b,o)); }
    B2=2.f*(64.f*C2*1.02f)*a*b; B2=__builtin_bit_cast(float,__builtin_amdgcn_readfirstlane(__builtin_bit_cast(int,B2))); }
  int cur_bh=-1;
  for(;;){
    int tid=threadIdx.x; asm volatile("":"+v"(tid)); const int lane=tid&63,wid=tid>>6;
    if(tid==0){ const unsigned n=__hip_atomic_fetch_add(T.queue,1u,__ATOMIC_RELAXED,__HIP_MEMORY_SCOPE_AGENT); ((unsigned*)scan)[8]=n; }
    asm volatile("s_waitcnt vmcnt(0) lgkmcnt(0)\n\ts_barrier":::"memory");
    const unsigned n=(unsigned)__builtin_amdgcn_readfirstlane((int)((volatile unsigned*)scan)[8]);
    if(n>=512u)break;
    const int qb=15-(int)(n>>5),bh=(int)(n&31u);
    if(bh!=cur_bh){ cur_bh=bh;
      const f32x4_t*src=(const f32x4_t*)(T.logf+(long)bh*SEQ)+2*tid; const f32x4_t a=src[0],b=src[1];
      f32x4_t v0=a,v1=b; v0[1]+=v0[0]; v0[2]+=v0[1]; v0[3]+=v0[2]; v1[0]+=v0[3]; v1[1]+=v1[0]; v1[2]+=v1[1]; v1[3]+=v1[2];
      float inc=v1[3];
      _Pragma("unroll") for(int o=1;o<64;o<<=1){ const float t=__shfl_up(inc,o); if(lane>=o)inc+=t; }
      if(lane==63)scan[wid]=inc;
      asm volatile("s_waitcnt lgkmcnt(0)\n\ts_barrier":::"memory");
      float base=inc-v1[3]; for(int w=0;w<wid;++w)base+=scan[w];
      f32x4_t*cl=(f32x4_t*)(lds+LDS_C)+2*tid;
      cl[0]=(v0+base)*1.4426950408889634f; cl[1]=(v1+base)*1.4426950408889634f;
      asm volatile("s_waitcnt lgkmcnt(0)\n\ts_barrier":::"memory");
    }
    { const float*cl=(const float*)(lds+LDS_C); const int ntf=4*qb+4;
      if(wid==0){ const float thr=cl[qb*QB]+150.f+B2; const bool sk=(lane<ntf-4)&&(cl[64*lane+63]>thr);
        const int cnt=__popcll(__ballot(sk)); if(lane==0)((int*)scan)[9]=cnt&~1; }
      asm volatile("s_waitcnt lgkmcnt(0)\n\ts_barrier":::"memory");
    }
    const int t0=__builtin_amdgcn_readfirstlane(((volatile int*)scan)[9]);
    attn_unit<THRL>(bh/NHEAD,bh%NHEAD,qb,T.Q,T.K,T.V,T.Y,T.gfo,T.ssa,lds,t0);
  }
}
#undef SBAR
#undef WAIT_BAR
}
#define GAS __attribute__((address_space(1)))
#define LAS __attribute__((address_space(3)))
typedef unsigned short bf16;
typedef unsigned v4u __attribute__((ext_vector_type(4)));
typedef float f32x4 __attribute__((ext_vector_type(4)));
typedef short bf16x8 __attribute__((ext_vector_type(8)));
typedef GAS unsigned gu32;
typedef GAS unsigned long long gu64;
#define RLX_AGENT __ATOMIC_RELAXED, __HIP_MEMORY_SCOPE_AGENT
#define LDS_WAIT() asm volatile("s_waitcnt lgkmcnt(0)" ::: "memory")
#define VM_WAIT() asm volatile("s_waitcnt vmcnt(0)" ::: "memory")
__device__ __forceinline__ unsigned long long rt() { return __builtin_amdgcn_s_memrealtime(); }
__device__ __forceinline__ unsigned f2bf(float f) { unsigned u = __builtin_bit_cast(unsigned, f); return (u + 0x7fffu + ((u >> 16) & 1u)) >> 16; }
__device__ __forceinline__ unsigned pk2(float lo, float hi) { return f2bf(lo) | (f2bf(hi) << 16); }

#define XB_TMO      128
#define XB_XCNT(j)  (256  + 64 * (j))
#define XB_XSUB(j)  (1280 + 64 * (j))
#define XB_XGEN(j)  (2304 + 64 * (j))
#define XB_TOP      3328
#define XB_TOPGEN   3392
#define XCD_BAR_WORDS 3456
#define XB_GMASK(j)  (3456 + 64 * (j))
#define XB_LCNT(j)   (3968 + 64 * (j))
#define XCD_BAR_STRIDE 4480
#define XB_SPIN_CAP (1u << 18)

__device__ __forceinline__ unsigned xb_ld(unsigned* p)              { return __hip_atomic_load(p, __ATOMIC_RELAXED, __HIP_MEMORY_SCOPE_AGENT); }
__device__ __forceinline__ unsigned xb_add(unsigned* p, unsigned v) { return __hip_atomic_fetch_add(p, v, __ATOMIC_RELAXED, __HIP_MEMORY_SCOPE_AGENT); }
__device__ __forceinline__ unsigned xb_xcc_id() { return (unsigned)__builtin_amdgcn_s_getreg((3 << 11) | 20) & 0xFu; }
#define XB_SPIN(cond, bar) do { unsigned _sp = 0; while (cond) { __builtin_amdgcn_s_sleep(1); \
    if ((++_sp & 255u) == 0u) { if (xb_ld(&(bar)[XB_TMO])) break; if (_sp > XB_SPIN_CAP) { atomicAdd(&(bar)[XB_TMO], 1u); break; } } } } while (0)

struct XcdBarrier {
    unsigned* bar; unsigned x;
    volatile LAS unsigned* st;
};

__device__ __forceinline__ XcdBarrier xcd_barrier_post(unsigned* bar, volatile LAS unsigned* st) {
    XcdBarrier b; b.bar = bar; b.x = xb_xcc_id(); b.st = st;
    if (threadIdx.x == 0) { (void)xb_add(&bar[XB_XCNT(b.x)], 1u); (void)__hip_atomic_fetch_or(&bar[XB_GMASK(blockIdx.x & 7u)], 1u << b.x, __ATOMIC_RELAXED, __HIP_MEMORY_SCOPE_AGENT); }
    return b;
}
__device__ __forceinline__ void xcd_barrier_complete(unsigned* bar, unsigned x, unsigned& nloc, unsigned& nx) {
    const unsigned G = gridDim.x * gridDim.y * gridDim.z;
    unsigned sum, cnt, mine, sp = 0u;
    for (;;) {
        sum = 0u; cnt = 0u; mine = 0u;
#pragma unroll
        for (unsigned j = 0; j < 16; ++j) { const unsigned c = xb_ld(&bar[XB_XCNT(j)]); sum += c; cnt += (c > 0u) ? 1u : 0u; mine = (j == x) ? c : mine; }
        if (sum == G) break;
        __builtin_amdgcn_s_sleep(1);
        if ((++sp & 255u) == 0u) { if (xb_ld(&bar[XB_TMO])) break; if (sp > XB_SPIN_CAP) { atomicAdd(&bar[XB_TMO], 1u); break; } }
    }
    nloc = mine > 0u ? mine : 1u; nx = cnt > 0u ? cnt : 1u;
}

__device__ __forceinline__ void xcd_barrier(const XcdBarrier& b) {
    asm volatile("s_waitcnt vmcnt(0)" ::: "memory");
    __syncthreads();
    if (threadIdx.x == 0) {
        unsigned* bar = b.bar;
        __builtin_amdgcn_s_waitcnt(0);
        unsigned nloc = b.st[0], nx = b.st[1];
        if (nloc == 0u) { xcd_barrier_complete(bar, b.x, nloc, nx); b.st[0] = nloc; b.st[1] = nx; }
        const unsigned old = xb_add(&bar[XB_XSUB(b.x)], 1u);
        const unsigned gen = old / nloc;
        if (old + 1u == (gen + 1u) * nloc) {
            __builtin_amdgcn_fence(__ATOMIC_RELEASE, "agent");
            asm volatile("s_waitcnt vmcnt(0)" ::: "memory");
            const unsigned og = xb_add(&bar[XB_TOP], 1u);
            const unsigned tg = og / nx;
            if (og + 1u == (tg + 1u) * nx) xb_add(&bar[XB_TOPGEN], 1u);
            else XB_SPIN(xb_ld(&bar[XB_TOPGEN]) == tg, bar);
            __builtin_amdgcn_fence(__ATOMIC_ACQUIRE, "agent");
            xb_add(&bar[XB_XGEN(b.x)], 1u);
            asm volatile("s_waitcnt vmcnt(0)" ::: "memory");
        } else {
            XB_SPIN(xb_ld(&bar[XB_XGEN(b.x)]) == gen, bar);
            __builtin_amdgcn_fence(__ATOMIC_ACQUIRE, "agent");
            asm volatile("s_waitcnt vmcnt(0)" ::: "memory");
        }
    }
    __syncthreads();
}

__device__ __forceinline__ void grp_barrier(const XcdBarrier& b) {
    asm volatile("s_waitcnt vmcnt(0)" ::: "memory");
    __syncthreads();
    bool done = false;
    if (threadIdx.x == 0) {
        unsigned* bar = b.bar;
        __builtin_amdgcn_s_waitcnt(0);
        unsigned mode = b.st[2];
        if (mode == 0u) {
            bool ok = (gridDim.x == 256u);
#pragma unroll
            for (unsigned j = 0; j < 8; ++j) { const unsigned m = xb_ld(&bar[XB_GMASK(j)]); ok = ok && (m != 0u) && ((m & (m - 1u)) == 0u); }
            mode = ok ? 1u : 2u; b.st[2] = mode;
        }
        if (mode == 1u) {
            unsigned* cnt = &bar[XB_LCNT(blockIdx.x & 7u)];
            const unsigned old = xb_add(cnt, 1u); const unsigned target = (old / 32u + 1u) * 32u;
            XB_SPIN(xb_ld(cnt) < target, bar);
            __builtin_amdgcn_fence(__ATOMIC_ACQUIRE, "agent");
            asm volatile("s_waitcnt vmcnt(0)" ::: "memory");
        }
        b.st[3] = mode;
    }
    __syncthreads();
    if (b.st[3] != 1u) xcd_barrier(b);
}
constexpr int NWAVES = 8;
constexpr int M = 16384, SEQ = 4096, DM = 1024, FF = 2816, INC = 2568, NMEM = 256;
constexpr float EPS = 1e-6f;
constexpr float LOG2E = 1.4426950408889634f;
constexpr float C2 = 0.125f * LOG2E, C2C = 0.0625f * LOG2E;
constexpr size_t MiB = 1u << 20;
constexpr size_t WS_CTL = 0, CTL_ZERO_BYTES = 1 * MiB;
constexpr size_t SS_OFF = 512 * 1024;
constexpr size_t WS_W1IN = 2 * MiB, WS_WCKV = 13 * MiB, WS_W1OUT = 17 * MiB, WS_WIN = 22 * MiB + 512 * 1024, WS_WOUT = 27 * MiB + 512 * 1024, WS_WCQ = 29 * MiB + 512 * 1024, WS_WCO = 31 * MiB + 512 * 1024,
                 WS_W2IN = 33 * MiB + 512 * 1024, WS_W2OUT = 44 * MiB + 512 * 1024;
constexpr size_t WS_XN = 50 * MiB, WS_MN = 82 * MiB, WS_KVRAW = 84 * MiB, WS_LOGF = 88 * MiB, WS_CUM = 88 * MiB + 512 * 1024;
constexpr size_t WS_Y = 90 * MiB, WS_ACT = 122 * MiB;
constexpr size_t WS_Q = 122 * MiB, WS_K = 138 * MiB, WS_V = 154 * MiB, WS_U = 170 * MiB, WS_VG = 186 * MiB, WS_QC = WS_Y, WS_OC = WS_Y  , WS_KC = 210 * MiB, WS_VT = 212 * MiB, WS_END = 214 * MiB;
static_assert(WS_WCKV == WS_W1IN + (size_t)2 * FF * DM * 2, "Wckv copy must follow W1in copy (combined GEMM phase)");
static_assert(WS_MN == WS_XN + (size_t)M * DM * 2, "MN must follow XN (combined GEMM phase)");
constexpr int CW_BAR = 4096, CW_AQ = 2048;
constexpr int RING_OFF = 0, LDSCTL_OFF = 139264, MISC_OFF = LDSCTL_OFF + 320, LDS_BYTES = 143360;
static_assert(attn_body::ATTN_LDS_BYTES <= LDSCTL_OFF && pg8::STAGE_BYTES <= LDSCTL_OFF, "LDS map");

struct Frame {
    LAS unsigned char* lds; volatile LAS unsigned* MISC; gu32* ctl;
    int tid, lane, wave, vcu, G;
};
struct Args { const float* in[26]; float* out; unsigned char* ws; int ph_lo, ph_hi, li, pad; };

__device__ __forceinline__ float wave_sum(float v) {
#pragma unroll
    for (int o = 1; o < 64; o <<= 1) v += __shfl_xor(v, o);
    return v;
}
struct TItem { const float* src; bf16* dst; const float* gk; int ldw, K; };
__device__ __forceinline__ void titem_load(const TItem& t, int lane, float (&v)[32]) {
    const float* p = t.src + (size_t)(lane >> 5) * t.ldw + (lane & 31);
#pragma unroll
    for (int i = 0; i < 32; ++i) v[i] = __builtin_nontemporal_load(p + (size_t)(2 * i) * t.ldw);
}
__device__ __forceinline__ void titem_finish(const TItem& t, int lane, LAS float* scr, const float (&v)[32]) {
    const int c = lane & 7;
    f32x4 g0 = {1.f, 1.f, 1.f, 1.f}, g1 = g0; if (t.gk) { g0 = *(const f32x4*)(t.gk + 8 * c); g1 = *(const f32x4*)(t.gk + 8 * c + 4); }
#pragma unroll
    for (int i = 0; i < 32; ++i) scr[(2 * i + (lane >> 5)) * 33 + (lane & 31)] = v[i];
    LDS_WAIT(); asm volatile("" ::: "memory");
#pragma unroll
    for (int j = 0; j < 4; ++j) { const int n = (lane >> 3) + 8 * j; const LAS float* s = scr + (8 * c) * 33 + n;
        v4u o; o.x = pk2(s[0 * 33] * g0.x, s[1 * 33] * g0.y); o.y = pk2(s[2 * 33] * g0.z, s[3 * 33] * g0.w); o.z = pk2(s[4 * 33] * g1.x, s[5 * 33] * g1.y); o.w = pk2(s[6 * 33] * g1.z, s[7 * 33] * g1.w);
        *(GAS v4u*)(t.dst + (size_t)n * t.K + 8 * c) = o; }
    LDS_WAIT(); asm volatile("" ::: "memory");
}
__device__ __forceinline__ TItem titem_make(const float* W, int ldw, int K, int src_col0, bf16* WT, int dst_row0, int kb, const float* gk = nullptr) {
    TItem t; t.src = W + (size_t)(64 * kb) * ldw + src_col0; t.dst = WT + (size_t)dst_row0 * K + 64 * kb; t.gk = gk ? gk + 64 * kb : nullptr; t.ldw = ldw; t.K = K; return t;
}
__device__ __forceinline__ int ffn_src_col(int db) { const int pn = db >> 3, w = db & 7; return (w >> 2) * FF + 128 * pn + 32 * (w & 3); }
__device__ __forceinline__ int mix_src_col(int db) { const int pn = db >> 3, w = db & 7;
    if (pn < 4) return (pn < 2 ? 0 : 512) + 256 * (pn & 1) + 64 * (w & 3) + 32 * (w >> 2);
    if (pn < 6) return 1024 + 256 * (pn - 4) + 32 * w;
    return 1544 + 256 * (pn - 6) + 32 * w; }
__device__ __forceinline__ void rms_row_to_bf16(int lane, const float* xrow, const float* g, bf16* orow) {
    const GAS f32x4* xr = (const GAS f32x4*)xrow + lane; const GAS f32x4* gr = (const GAS f32x4*)g + lane;
    f32x4 v[4]; float s = 0.f;
#pragma unroll
    for (int j = 0; j < 4; ++j) { v[j] = xr[64 * j]; s += (v[j].x * v[j].x + v[j].y * v[j].y) + (v[j].z * v[j].z + v[j].w * v[j].w); }
    const float rstd = rsqrtf(wave_sum(s) * (1.f / DM) + EPS);
    GAS unsigned long long* o8 = (GAS unsigned long long*)orow + lane;
#pragma unroll
    for (int j = 0; j < 4; ++j) { const f32x4 gg = gr[64 * j]; o8[64 * j] = (unsigned long long)pk2(v[j].x * rstd * gg.x, v[j].y * rstd * gg.y) | ((unsigned long long)pk2(v[j].z * rstd * gg.z, v[j].w * rstd * gg.w) << 32); }
}
constexpr int TI0 = 16 * 176, TI1 = 16 * 64, TI2 = 44 * 32, TI3 = 16 * 80, TI4 = 16 * 32;
constexpr int IG0 = TI0 + TI1 + TI2, IG1 = IG0 + TI3 + 3 * TI4, IG2 = IG1 + TI0 + TI2;
__device__ __forceinline__ TItem titem_decode(const Args& a, int it) {
    unsigned char* ws = a.ws; int r = it;
    if (r < TI0) { const int kb = r / 176, db = r % 176; return titem_make(a.in[3], 2 * FF, DM, ffn_src_col(db), (bf16*)(ws + WS_W1IN), 32 * db, kb); } r -= TI0;
    if (r < TI1) { const int kb = r / 64, db = r % 64; return titem_make(a.in[19], 2048, DM, 32 * db, (bf16*)(ws + WS_WCKV), 32 * db, kb); } r -= TI1;
    if (r < TI2) { const int kb = r / 32, db = r % 32; return titem_make(a.in[4], DM, FF, 32 * db, (bf16*)(ws + WS_W1OUT), 32 * db, kb); } r -= TI2;
    if (r < TI3) { const int kb = r / 80, db = r % 80; return titem_make(a.in[6], INC, DM, mix_src_col(db), (bf16*)(ws + WS_WIN), 32 * db, kb, a.in[5]); } r -= TI3;
    if (r < TI4) { const int kb = r / 32, db = r % 32; return titem_make(a.in[15], DM, DM, 32 * db, (bf16*)(ws + WS_WOUT), 32 * db, kb); } r -= TI4;
    if (r < TI4) { const int kb = r / 32, db = r % 32; return titem_make(a.in[18], DM, DM, 32 * db, (bf16*)(ws + WS_WCQ), 32 * db, kb, a.in[16]); } r -= TI4;
    if (r < TI4) { const int kb = r / 32, db = r % 32; return titem_make(a.in[22], DM, DM, 32 * db, (bf16*)(ws + WS_WCO), 32 * db, kb); } r -= TI4;
    if (r < TI0) { const int kb = r / 176, db = r % 176; return titem_make(a.in[24], 2 * FF, DM, ffn_src_col(db), (bf16*)(ws + WS_W2IN), 32 * db, kb, a.in[23]); } r -= TI0;
    { const int kb = r / 32, db = r % 32; return titem_make(a.in[25], DM, FF, 32 * db, (bf16*)(ws + WS_W2OUT), 32 * db, kb); }
}
__device__ __forceinline__ void transpose_range(Frame& F, const Args& a, int first, int last, int gw, int ngw) {
    LAS float* scr = (LAS float*)(F.lds + RING_OFF + F.wave * 16384);
    int it = first + gw; if (it >= last) return;
    float va[32], vb[32];
    TItem ta = titem_decode(a, it), tb = ta; titem_load(ta, F.lane, va);
    for (;;) {
        const int it2 = it + ngw; const bool h2 = it2 < last;
        if (h2) { tb = titem_decode(a, it2); titem_load(tb, F.lane, vb); }
        titem_finish(ta, F.lane, scr, va);
        if (!h2) break;
        const int it3 = it2 + ngw; const bool h3 = it3 < last;
        if (h3) { ta = titem_decode(a, it3); titem_load(ta, F.lane, va); }
        titem_finish(tb, F.lane, scr, vb);
        if (!h3) break;
        it = it3;
    }
}
__device__ __forceinline__ void rms_2rows_to_bf16(int lane, const float* xa, const float* ga, bf16* oa, const float* xb, const float* gb, bf16* ob) {
    const GAS f32x4* xra = (const GAS f32x4*)xa + lane; const GAS f32x4* xrb = (const GAS f32x4*)xb + lane;
    f32x4 va[4], vb[4]; float sa = 0.f, sb = 0.f;
#pragma unroll
    for (int j = 0; j < 4; ++j) { va[j] = __builtin_nontemporal_load(xra + 64 * j); vb[j] = __builtin_nontemporal_load(xrb + 64 * j); }
#pragma unroll
    for (int j = 0; j < 4; ++j) { sa += (va[j].x * va[j].x + va[j].y * va[j].y) + (va[j].z * va[j].z + va[j].w * va[j].w); sb += (vb[j].x * vb[j].x + vb[j].y * vb[j].y) + (vb[j].z * vb[j].z + vb[j].w * vb[j].w); }
    const float ra = rsqrtf(wave_sum(sa) * (1.f / DM) + EPS), rb = rsqrtf(wave_sum(sb) * (1.f / DM) + EPS);
    const GAS f32x4* gra = (const GAS f32x4*)ga + lane; const GAS f32x4* grb = (const GAS f32x4*)gb + lane;
    GAS unsigned long long* o8a = (GAS unsigned long long*)oa + lane; GAS unsigned long long* o8b = (GAS unsigned long long*)ob + lane;
#pragma unroll
    for (int j = 0; j < 4; ++j) { const f32x4 gg = gra[64 * j]; o8a[64 * j] = (unsigned long long)pk2(va[j].x * ra * gg.x, va[j].y * ra * gg.y) | ((unsigned long long)pk2(va[j].z * ra * gg.z, va[j].w * ra * gg.w) << 32); }
#pragma unroll
    for (int j = 0; j < 4; ++j) { const f32x4 gg = grb[64 * j]; o8b[64 * j] = (unsigned long long)pk2(vb[j].x * rb * gg.x, vb[j].y * rb * gg.y) | ((unsigned long long)pk2(vb[j].z * rb * gg.z, vb[j].w * rb * gg.w) << 32); }
}
__device__ __forceinline__ void p0_prologue(Frame& F, const Args& a) {
    const int gw = F.vcu * NWAVES + F.wave, NGW = F.G * NWAVES;
    transpose_range(F, a, 0, IG0, gw, NGW);
    bf16* XN = (bf16*)(a.ws + WS_XN);
    for (int m = gw; m < M + 1024; m += 2 * NGW) {
        const int m2 = m + NGW; const bool has2 = m2 < M + 1024;
        const float* xa = m < M ? a.in[0] + (size_t)m * DM : a.in[1] + (size_t)(m - M) * DM; const float* ga = m < M ? a.in[2] : a.in[17];
        const float* xb = !has2 ? xa : (m2 < M ? a.in[0] + (size_t)m2 * DM : a.in[1] + (size_t)(m2 - M) * DM); const float* gb = (has2 && m2 >= M) ? a.in[17] : (has2 ? a.in[2] : ga);
        rms_2rows_to_bf16(F.lane, xa, ga, XN + (size_t)m * DM, xb, gb, XN + (size_t)(has2 ? m2 : m) * DM);
    }
}
__device__ __forceinline__ void p3_prelude(Frame& F, const Args& a, int gw, int ngw) {
    unsigned char* ws = a.ws; const int lane = F.lane;
    const bf16* XN = (const bf16*)(ws + WS_XN); const float* ss2 = (const float*)(ws + SS_OFF); float* LOGF = (float*)(ws + WS_LOGF);
    {
        f32x4 wf[16][2];
        const float* wp = a.in[6] + (size_t)(16 * lane) * INC + 1536;
#pragma unroll
        for (int kk = 0; kk < 16; ++kk) { const float gm = a.in[5][16 * lane + kk]; wf[kk][0] = *(const f32x4*)(wp + (size_t)kk * INC) * gm; wf[kk][1] = *(const f32x4*)(wp + (size_t)kk * INC + 4) * gm; }
        const float bfl = a.in[7][lane & 7];
        for (int mb = gw; mb < M; mb += 4 * ngw) {
          v4u xq[4][2];
#pragma unroll
          for (int r = 0; r < 4; ++r) { const int m = mb + r * ngw < M ? mb + r * ngw : mb; xq[r][0] = *(const GAS v4u*)(XN + (size_t)m * DM + 16 * lane); xq[r][1] = *(const GAS v4u*)(XN + (size_t)m * DM + 16 * lane + 8); }
#pragma unroll
          for (int r = 0; r < 4; ++r) { const int m = mb + r * ngw; if (m >= M) break;
            const v4u x0 = xq[r][0], x1 = xq[r][1];
            f32x4 d0 = {0.f, 0.f, 0.f, 0.f}, d1 = {0.f, 0.f, 0.f, 0.f};
#pragma unroll
            for (int e = 0; e < 4; ++e) { const float lo = __uint_as_float(x0[e] << 16), hi = __uint_as_float(x0[e] & 0xffff0000u);
                d0 += wf[2 * e][0] * lo + wf[2 * e + 1][0] * hi; d1 += wf[2 * e][1] * lo + wf[2 * e + 1][1] * hi; }
#pragma unroll
            for (int e = 0; e < 4; ++e) { const float lo = __uint_as_float(x1[e] << 16), hi = __uint_as_float(x1[e] & 0xffff0000u);
                d0 += wf[8 + 2 * e][0] * lo + wf[8 + 2 * e + 1][0] * hi; d1 += wf[8 + 2 * e][1] * lo + wf[8 + 2 * e + 1][1] * hi; }
#pragma unroll
            for (int h = 0; h < 4; ++h) { d0[h] = wave_sum(d0[h]); d1[h] = wave_sum(d1[h]); }
            const int hsel = lane & 7;
            float mine = d0[0];
            mine = hsel == 1 ? d0[1] : mine; mine = hsel == 2 ? d0[2] : mine; mine = hsel == 3 ? d0[3] : mine;
            mine = hsel == 4 ? d1[0] : mine; mine = hsel == 5 ? d1[1] : mine; mine = hsel == 6 ? d1[2] : mine; mine = hsel == 7 ? d1[3] : mine;
            const float y = mine * rsqrtf(ss2[m] * (1.f / DM) + EPS) + bfl;
            const float lf = fminf(y, 0.f) - log1pf(expf(-fabsf(y)));
            if (lane < 8) LOGF[(size_t)((m >> 12) * 8 + lane) * SEQ + (m & 4095)] = lf;
          }
        }
    }
    const bf16* KV = (const bf16*)(ws + WS_KVRAW); bf16* KC = (bf16*)(ws + WS_KC); bf16* VT = (bf16*)(ws + WS_VT);
    for (int task = gw; task < 4096; task += ngw) {
        const int mr = task >> 2, h = task & 3; const unsigned long long raw = *(const GAS unsigned long long*)(KV + (size_t)mr * 2048 + h * 256 + 4 * lane);
        const float v0 = __uint_as_float((unsigned)raw << 16), v1 = __uint_as_float((unsigned)raw & 0xffff0000u), v2 = __uint_as_float((unsigned)(raw >> 32) << 16), v3 = __uint_as_float((unsigned)(raw >> 32) & 0xffff0000u);
        const float rs = rsqrtf(wave_sum((v0 * v0 + v1 * v1) + (v2 * v2 + v3 * v3)) * (1.f / 256.f) + EPS); const f32x4 g = *(const f32x4*)(a.in[21] + 4 * lane);
        *(GAS unsigned long long*)(KC + (size_t)mr * DM + h * 256 + 4 * lane) = (unsigned long long)pk2(v0 * rs * g.x, v1 * rs * g.y) | ((unsigned long long)pk2(v2 * rs * g.z, v3 * rs * g.w) << 32);
    }
    for (int L = gw * 64 + lane; L < 131072; L += ngw * 64) {
        const int c = L & 1023, j0 = ((L >> 10) & 31) * 8, b = L >> 15; v4u o;
#pragma unroll
        for (int i = 0; i < 4; ++i) o[i] = (unsigned)KV[(size_t)(b * 256 + j0 + 2 * i) * 2048 + 1024 + c] | ((unsigned)KV[(size_t)(b * 256 + j0 + 2 * i + 1) * 2048 + 1024 + c] << 16);
        *(GAS v4u*)(VT + (size_t)(b * 1024 + c) * 256 + j0) = o;
    }
}
__device__ __forceinline__ void sgu_phase(Frame& F, const Args& a, bool do_ss) {
    unsigned char* ws = a.ws; int tid = threadIdx.x; asm volatile("" : "+v"(tid));
    const int lane = tid & 63, wid = __builtin_amdgcn_readfirstlane(tid >> 6), fr = lane & 15, kq = lane >> 4;
    constexpr int RS = 272;
    LAS unsigned char* Wt = F.lds; LAS unsigned char* Vt = F.lds + 128 * RS;
    const int g = F.vcu & 7;
    const bf16* U = (const bf16*)(ws + WS_U); const bf16* VG = (const bf16*)(ws + WS_VG); const float* ssv = (const float*)(ws + SS_OFF) + M; float* ssg = (float*)(ws + SS_OFF) + 3 * M; bf16* Y = (bf16*)(ws + WS_Y);
    {
        const int t = tid >> 2, s0 = (tid & 3) * 32; const float* wp = a.in[11] + (size_t)(g * 128 + t) * 128 + s0;
#pragma unroll
        for (int q = 0; q < 4; ++q) { const f32x4 x0 = *(const f32x4*)(wp + 8 * q), x1 = *(const f32x4*)(wp + 8 * q + 4); const int s = s0 + 8 * q; v4u o;
            o.x = pk2(s + 0 <= t ? x0.x : 0.f, s + 1 <= t ? x0.y : 0.f); o.y = pk2(s + 2 <= t ? x0.z : 0.f, s + 3 <= t ? x0.w : 0.f);
            o.z = pk2(s + 4 <= t ? x1.x : 0.f, s + 5 <= t ? x1.y : 0.f); o.w = pk2(s + 6 <= t ? x1.z : 0.f, s + 7 <= t ? x1.w : 0.f);
            *(LAS v4u*)(Wt + t * RS + s * 2) = o; }
    }
    const int sst = tid >> 2, d0 = (tid & 3) * 16; const float* gp = a.in[10] + g * 64 + d0;
    const int rowA = (F.vcu >> 3) * 512;
    v4u x0 = *(const GAS v4u*)(VG + (size_t)(rowA + sst) * 512 + g * 64 + d0), x1 = *(const GAS v4u*)(VG + (size_t)(rowA + sst) * 512 + g * 64 + d0 + 8); float ssq = ssv[rowA + sst];
#pragma unroll
    for (int ui = 0; ui < 4; ++ui) {
        const int row0 = rowA + ui * 128;
        {
            const float rs = rsqrtf(ssq * (1.f / 512.f) + EPS);
#pragma unroll
            for (int e = 0; e < 4; ++e) { const float lo = __uint_as_float(x0[e] << 16) * rs * gp[2 * e], hi = __uint_as_float(x0[e] & 0xffff0000u) * rs * gp[2 * e + 1];
                *(LAS unsigned short*)(Vt + (d0 + 2 * e) * RS + sst * 2) = (unsigned short)f2bf(lo); *(LAS unsigned short*)(Vt + (d0 + 2 * e + 1) * RS + sst * 2) = (unsigned short)f2bf(hi); }
#pragma unroll
            for (int e = 0; e < 4; ++e) { const float lo = __uint_as_float(x1[e] << 16) * rs * gp[8 + 2 * e], hi = __uint_as_float(x1[e] & 0xffff0000u) * rs * gp[8 + 2 * e + 1];
                *(LAS unsigned short*)(Vt + (d0 + 8 + 2 * e) * RS + sst * 2) = (unsigned short)f2bf(lo); *(LAS unsigned short*)(Vt + (d0 + 8 + 2 * e + 1) * RS + sst * 2) = (unsigned short)f2bf(hi); }
        }
        const int t = 16 * wid + fr, row = row0 + t;
        unsigned long long uu[4];
#pragma unroll
        for (int ib = 0; ib < 4; ++ib) uu[ib] = *(const GAS unsigned long long*)(U + (size_t)row * 512 + g * 64 + 16 * ib + 4 * kq);
        if (ui < 3) { const size_t nr = (size_t)(row0 + 128 + sst); x0 = *(const GAS v4u*)(VG + nr * 512 + g * 64 + d0); x1 = *(const GAS v4u*)(VG + nr * 512 + g * 64 + d0 + 8); ssq = ssv[row0 + 128 + sst]; }
        __syncthreads();
        f32x4 acc[4];
#pragma unroll
        for (int ib = 0; ib < 4; ++ib) acc[ib] = (f32x4){0.f, 0.f, 0.f, 0.f};
#pragma unroll
        for (int ks = 0; ks < 4; ++ks) { const bf16x8 wfr = *(const LAS bf16x8*)(Wt + (16 * wid + fr) * RS + (32 * ks + 8 * kq) * 2);
#pragma unroll
            for (int ib = 0; ib < 4; ++ib) { const bf16x8 vfr = *(const LAS bf16x8*)(Vt + (16 * ib + fr) * RS + (32 * ks + 8 * kq) * 2); acc[ib] = __builtin_amdgcn_mfma_f32_16x16x32_bf16(vfr, wfr, acc[ib], 0, 0, 0); } }
        const float bias = a.in[12][g * 128 + t]; float sq = 0.f;
#pragma unroll
        for (int ib = 0; ib < 4; ++ib) { const int c = g * 64 + 16 * ib + 4 * kq; const unsigned long long u8 = uu[ib];
            const float u0 = __uint_as_float((unsigned)u8 << 16), u1 = __uint_as_float((unsigned)u8 & 0xffff0000u), u2 = __uint_as_float((unsigned)(u8 >> 32) << 16), u3 = __uint_as_float((unsigned)(u8 >> 32) & 0xffff0000u);
            const float s0 = u0 * (acc[ib][0] + bias), s1 = u1 * (acc[ib][1] + bias), s2 = u2 * (acc[ib][2] + bias), s3 = u3 * (acc[ib][3] + bias); sq += (s0 * s0 + s1 * s1) + (s2 * s2 + s3 * s3);
            const f32x4 go = *(const f32x4*)(a.in[14] + c);
            *(GAS unsigned long long*)(Y + (size_t)row * 1024 + 512 + c) = (unsigned long long)pk2(s0 * go.x, s1 * go.y) | ((unsigned long long)pk2(s2 * go.z, s3 * go.w) << 32); }
        sq += __shfl_xor(sq, 16); sq += __shfl_xor(sq, 32); if (kq == 0 && do_ss) atomicAdd(ssg + row, sq);
        __syncthreads();
    }
}
__device__ __forceinline__ void xattn_units(Frame& F, const Args& a, int b, int h, int qrow0) {
    typedef short s16x4 __attribute__((ext_vector_type(4)));
    unsigned char* ws = a.ws; const int tid = F.tid, lane = F.lane, wid = F.wave, fr = lane & 15, kq = lane >> 4;
    constexpr int RS = 528;
    LAS unsigned char* L = F.lds;
    const bf16* QC = (const bf16*)(ws + WS_QC); const bf16* KC = (const bf16*)(ws + WS_KC); const bf16* VT = (const bf16*)(ws + WS_VT); bf16* OC = (bf16*)(ws + WS_OC);
    v4u st[16];
#pragma unroll
    for (int i = 0; i < 16; ++i) { const int ch = tid + 512 * i, j = ch >> 5, c16 = ch & 31; st[i] = *(const GAS v4u*)(KC + (size_t)(b * NMEM + j) * DM + h * 256 + c16 * 8); }
#pragma unroll
    for (int i = 0; i < 16; ++i) { const int ch = tid + 512 * i, j = ch >> 5, c16 = ch & 31; *(LAS v4u*)(L + j * RS + c16 * 16) = st[i]; }
    __syncthreads();
    bf16x8 pf[2][8]; float inv[2]; bf16x8 qf[2][8];
    const int rowq = b * SEQ + qrow0 + wid * 16;
#pragma unroll
    for (int hh = 0; hh < 2; ++hh)
#pragma unroll
        for (int ks = 0; ks < 8; ++ks) qf[hh][ks] = *(const GAS bf16x8*)(QC + (size_t)(rowq + hh * 128 + fr) * DM + h * 256 + 32 * ks + 8 * kq);
    float sum0 = 0.f, sum1 = 0.f;
#pragma unroll
    for (int k2 = 0; k2 < 8; ++k2) {
        f32x4 a00 = {0.f, 0.f, 0.f, 0.f}, a01 = a00, a10 = a00, a11 = a00;
#pragma unroll
        for (int ks = 0; ks < 8; ++ks) {
            const bf16x8 kA = *(const LAS bf16x8*)(L + (32 * k2 + fr) * RS + (32 * ks + 8 * kq) * 2), kB = *(const LAS bf16x8*)(L + (32 * k2 + 16 + fr) * RS + (32 * ks + 8 * kq) * 2);
            a00 = __builtin_amdgcn_mfma_f32_16x16x32_bf16(kA, qf[0][ks], a00, 0, 0, 0); a01 = __builtin_amdgcn_mfma_f32_16x16x32_bf16(kB, qf[0][ks], a01, 0, 0, 0);
            a10 = __builtin_amdgcn_mfma_f32_16x16x32_bf16(kA, qf[1][ks], a10, 0, 0, 0); a11 = __builtin_amdgcn_mfma_f32_16x16x32_bf16(kB, qf[1][ks], a11, 0, 0, 0); }
#pragma unroll
        for (int e = 0; e < 4; ++e) { a00[e] = __builtin_amdgcn_exp2f(a00[e]); a01[e] = __builtin_amdgcn_exp2f(a01[e]); a10[e] = __builtin_amdgcn_exp2f(a10[e]); a11[e] = __builtin_amdgcn_exp2f(a11[e]); }
        sum0 += (a00[0] + a00[1]) + (a00[2] + a00[3]) + (a01[0] + a01[1]) + (a01[2] + a01[3]); sum1 += (a10[0] + a10[1]) + (a10[2] + a10[3]) + (a11[0] + a11[1]) + (a11[2] + a11[3]);
        { const v4u w = {pk2(a00[0], a00[1]), pk2(a00[2], a00[3]), pk2(a01[0], a01[1]), pk2(a01[2], a01[3])}; pf[0][k2] = __builtin_bit_cast(bf16x8, w); }
        { const v4u w = {pk2(a10[0], a10[1]), pk2(a10[2], a10[3]), pk2(a11[0], a11[1]), pk2(a11[2], a11[3])}; pf[1][k2] = __builtin_bit_cast(bf16x8, w); }
    }
    sum0 += __shfl_xor(sum0, 16); sum0 += __shfl_xor(sum0, 32); sum1 += __shfl_xor(sum1, 16); sum1 += __shfl_xor(sum1, 32);
    inv[0] = 1.f / sum0; inv[1] = 1.f / sum1;
    asm volatile("" ::: "memory");
#pragma unroll
    for (int i = 0; i < 16; ++i) { const int ch = tid + 512 * i, d = ch >> 5, c16 = ch & 31; st[i] = *(const GAS v4u*)(VT + (size_t)(b * 1024 + h * 256 + d) * NMEM + c16 * 8); }
    __syncthreads();
#pragma unroll
    for (int i = 0; i < 16; ++i) { const int ch = tid + 512 * i, d = ch >> 5, c16 = ch & 31; *(LAS v4u*)(L + d * RS + c16 * 16) = st[i]; }
    __syncthreads();
#pragma unroll 2
    for (int db = 0; db < 16; ++db) { f32x4 acc0 = {0.f, 0.f, 0.f, 0.f}, acc1 = acc0;
#pragma unroll
        for (int k2 = 0; k2 < 8; ++k2) { const s16x4 lo = *(const LAS s16x4*)(L + (16 * db + fr) * RS + (32 * k2 + 4 * kq) * 2), hi = *(const LAS s16x4*)(L + (16 * db + fr) * RS + (32 * k2 + 16 + 4 * kq) * 2);
            const bf16x8 vfr = {lo[0], lo[1], lo[2], lo[3], hi[0], hi[1], hi[2], hi[3]};
            acc0 = __builtin_amdgcn_mfma_f32_16x16x32_bf16(vfr, pf[0][k2], acc0, 0, 0, 0); acc1 = __builtin_amdgcn_mfma_f32_16x16x32_bf16(vfr, pf[1][k2], acc1, 0, 0, 0); }
        *(GAS unsigned long long*)(OC + (size_t)(rowq + fr) * DM + h * 256 + 16 * db + 4 * kq) = (unsigned long long)pk2(acc0[0] * inv[0], acc0[1] * inv[0]) | ((unsigned long long)pk2(acc0[2] * inv[0], acc0[3] * inv[0]) << 32);
        *(GAS unsigned long long*)(OC + (size_t)(rowq + 128 + fr) * DM + h * 256 + 16 * db + 4 * kq) = (unsigned long long)pk2(acc1[0] * inv[1], acc1[1] * inv[1]) | ((unsigned long long)pk2(acc1[2] * inv[1], acc1[3] * inv[1]) << 32); }
    __syncthreads();
}
__global__ void __launch_bounds__(NWAVES * 64, 2) mk_fwd(Args args) {
    extern __shared__ __attribute__((aligned(16))) unsigned char lds[];
    Frame F;
    F.lds = (LAS unsigned char*)lds; F.MISC = (volatile LAS unsigned*)(F.lds + MISC_OFF);
    F.tid = threadIdx.x; F.lane = F.tid & 63; F.wave = __builtin_amdgcn_readfirstlane(F.tid >> 6);
    F.G = gridDim.x; { const int bx = blockIdx.x; F.vcu = (F.G % 8 == 0) ? (bx % 8) * (F.G / 8) + bx / 8 : bx; }
    unsigned char* ws = args.ws; F.ctl = (gu32*)(ws + WS_CTL);
    { int u0 = F.tid; asm volatile("" : "+v"(u0));
      for (int u = u0; u < (LDS_BYTES - LDSCTL_OFF) / 4; u += NWAVES * 64) ((LAS unsigned*)(F.lds + LDSCTL_OFF))[u] = 0u; }
    __syncthreads();
    XcdBarrier bar = xcd_barrier_post((unsigned*)(F.ctl + CW_BAR) + args.li * XCD_BAR_STRIDE, F.MISC + 8);
    const int lo = args.ph_lo, hi = args.ph_hi;
#ifndef PH_MASK
#define PH_MASK 0x7ff
#endif
#define IN(k) ((((PH_MASK) >> (k)) & 1) && lo <= (k) && (k) < hi)
#ifndef PROBE_BAR
#define PROBE_BAR 1
#endif
#define SEAM(k) do { if (IN(k) && IN((k) + 1)) { for (int nb_ = 0; nb_ < PROBE_BAR; ++nb_) xcd_barrier(bar); } } while (0)
#ifndef LOCAL_SEAMS
#define LOCAL_SEAMS 1
#endif
#define LSEAM(k) do { if (IN(k) && IN((k) + 1)) { if (LOCAL_SEAMS) grp_barrier(bar); else xcd_barrier(bar); } } while (0)
    float* ssb = (float*)(ws + SS_OFF); float *ss2 = ssb, *ssv = ssb + M, *ssa = ssb + 2 * M, *ssg = ssb + 3 * M, *ss3 = ssb + 4 * M, *ss4 = ssb + 5 * M;
    pg8::bf16_t* XN = (pg8::bf16_t*)(ws + WS_XN); pg8::bf16_t* ACT = (pg8::bf16_t*)(ws + WS_ACT); pg8::bf16_t* Y = (pg8::bf16_t*)(ws + WS_Y);
    float* out = args.out;
    const int bid = (int)blockIdx.x;

#ifndef PROBE_DUP
#define PROBE_DUP -1
#endif
#if PROBE_DUP >= 0
    const int rp = args.pad;
#else
    constexpr int rp = 0;
#endif
#define REPS(k)
#ifndef PROBE_PASSES
#define PROBE_PASSES 1
#endif
    if (IN(0)) { REPS(0) p0_prologue(F, args); SEAM(0); }
    if (IN(1)) {
        pg8::Gemm g{XN, (const pg8::bf16_t*)(ws + WS_W1IN), M + 1024, 2 * FF + 2048, DM}; pg8::ComboOrder S; S.init(M, 2 * FF, F.G, bid, 32, 64, 22, 4);
        pg8::EpiSwiGLU E{ACT, nullptr, (pg8::bf16_t*)(ws + WS_KVRAW), 22, 64};
        REPS(1) pg8::gemm_phase<pg8::EpiSwiGLU, pg8::ComboOrder, PG8_ALIGN, PG8_SP2>(F.lds + RING_OFF, g, S, E);
        if (bid >= 160 && rp == 0) transpose_range(F, args, IG0, IG1, (bid - 160) * NWAVES + F.wave, (F.G - 160) * NWAVES);
        LSEAM(1); }
    if (IN(2)) {
        pg8::Gemm g{ACT, (const pg8::bf16_t*)(ws + WS_W1OUT), M, DM, FF}; pg8::StaticOrder S; S.init(M, DM, F.G, bid);
        REPS(2) { pg8::EpiRes<0, false, true> E{args.in[0], XN, 0.5f, nullptr, nullptr, rp ? nullptr : ss2};
        pg8::gemm_phase<pg8::EpiRes<0, false, true>, pg8::StaticOrder, PG8_ALIGN, PG8_SP2>(F.lds + RING_OFF, g, S, E); } SEAM(2); }
    if (IN(3)) {
        REPS(3) {
        p3_prelude(F, args, F.vcu * NWAVES + F.wave, F.G * NWAVES);
        pg8::Gemm g{XN, (const pg8::bf16_t*)(ws + WS_WIN), M, 2560, DM}; pg8::StaticOrder S; S.init(M, 2560, F.G, bid);
        static_assert(WS_K - WS_Q == 16 * MiB && WS_V - WS_K == 16 * MiB && WS_U - WS_V == 16 * MiB && WS_VG - WS_U == 16 * MiB, "EpiMix addresses Q|K|V|U|VG by stride");
        pg8::EpiMix E{ss2, args.in[8], args.in[9], (pg8::bf16_t*)(ws + WS_Q), rp ? nullptr : ssv};
        pg8::gemm_phase<pg8::EpiMix, pg8::StaticOrder, PG8_ALIGN, PG8_SP2>(F.lds + RING_OFF, g, S, E); }
        if (bid >= 128 && rp == 0) transpose_range(F, args, IG1, IG2, (bid - 128) * NWAVES + F.wave, (F.G - 128) * NWAVES);
        SEAM(3); }
    if (IN(4)) {
        REPS(4) {
        const attn_body::AttnTensors AT{(const attn_body::bf16*)(ws + WS_Q), (const attn_body::bf16*)(ws + WS_K), (const attn_body::bf16*)(ws + WS_V), (unsigned short*)Y, args.in[13], rp ? nullptr : ssa, (const float*)(ws + WS_LOGF), args.in[8], args.in[9], (unsigned*)(F.ctl + CW_AQ)};
        const attn_body::StaticOrder S((int)F.G, bid);
        sgu_phase(F, args, rp == 0);
        attn_body::attn_phase<attn_body::StaticOrder>((char*)lds + RING_OFF, AT, S); } SEAM(4); }
    if (IN(5)) {
        pg8::Gemm g{Y, (const pg8::bf16_t*)(ws + WS_WOUT), M, DM, DM}; pg8::StaticOrder S; S.init(M, DM, F.G, bid);
        REPS(5) { pg8::EpiRes<8, true, true> E{XN, XN, rp ? 0.0f : 1.0f, ssg, ssa, rp ? nullptr : ss3};
        pg8::gemm_phase<pg8::EpiRes<8, true, true>, pg8::StaticOrder, PG8_ALIGN, PG8_SP2>(F.lds + RING_OFF, g, S, E); } LSEAM(5); }
    if (IN(6)) {
        pg8::Gemm g{XN, (const pg8::bf16_t*)(ws + WS_WCQ), M, DM, DM}; pg8::StaticOrder S; S.init(M, DM, F.G, bid);
        pg8::EpiCQ E{ss3, args.in[20], (pg8::bf16_t*)(ws + WS_QC)};
        REPS(6) pg8::gemm_phase<pg8::EpiCQ, pg8::StaticOrder, false, PG8_SP2>(F.lds + RING_OFF, g, S, E);
        pg8::Unit u; if (S.next(0, u)) { asm volatile("s_waitcnt vmcnt(0)" ::: "memory"); __syncthreads(); xattn_units(F, args, u.pm >> 4, u.pn, (u.pm & 15) * 256); }
        LSEAM(7); }
    if (IN(8)) {
        pg8::Gemm g{(const pg8::bf16_t*)(ws + WS_OC), (const pg8::bf16_t*)(ws + WS_WCO), M, DM, DM}; pg8::StaticOrder S; S.init(M, DM, F.G, bid);
        REPS(8) { pg8::EpiRes<0, true, true> E{XN, XN, rp ? 0.0f : 1.0f, nullptr, nullptr, rp ? nullptr : ss4};
        pg8::gemm_phase<pg8::EpiRes<0, true, true>, pg8::StaticOrder, PG8_ALIGN, PG8_SP2>(F.lds + RING_OFF, g, S, E); } LSEAM(8); }
    if (IN(9)) {
        pg8::Gemm g{XN, (const pg8::bf16_t*)(ws + WS_W2IN), M, 2 * FF, DM}; pg8::ComboOrder S; S.init(M, 2 * FF, F.G, bid, 0, 64, 22, 4);
        pg8::EpiSwiGLU E{ACT, ss4, nullptr, 22, 64};
        REPS(9) pg8::gemm_phase<pg8::EpiSwiGLU, pg8::ComboOrder, PG8_ALIGN, PG8_SP2>(F.lds + RING_OFF, g, S, E); LSEAM(9); }
    if (IN(10)) {
        pg8::Gemm g{ACT, (const pg8::bf16_t*)(ws + WS_W2OUT), M, DM, FF}; pg8::StaticOrder S; S.init(M, DM, F.G, bid);
        REPS(10) { pg8::EpiRes<0, true, false> E{XN, out, rp ? 0.0f : 0.5f, nullptr, nullptr, nullptr};
        pg8::gemm_phase<pg8::EpiRes<0, true, false>, pg8::StaticOrder, PG8_ALIGN, PG8_SP2>(F.lds + RING_OFF, g, S, E); } }
#undef IN
#undef SEAM
}
#ifndef FAST_K
#define FAST_K 11
#endif
extern "C" void kernel_launch(void* const* d_in, const int* in_sizes, int n_in, void* d_out, int out_size, void* d_ws, size_t ws_size, hipStream_t stream) {
    static int grid = 0;
    if (grid == 0) {
        if (n_in != 26 || in_sizes[0] != M * DM || out_size != M * DM || ws_size < WS_END) { fprintf(stderr, "kernel_launch: unexpected problem shape (n_in %d, in0 %d, out %d, ws %zu)\n", n_in, n_in > 0 ? in_sizes[0] : -1, out_size, ws_size); grid = -1; return; }
        int dev = 0, cus = 0, per_cu = 0;
        if (hipGetDevice(&dev) != hipSuccess || hipDeviceGetAttribute(&cus, hipDeviceAttributeMultiprocessorCount, dev) != hipSuccess) { grid = -1; return; }
        if (hipFuncSetAttribute((const void*)mk_fwd, hipFuncAttributeMaxDynamicSharedMemorySize, LDS_BYTES) != hipSuccess) { fprintf(stderr, "kernel_launch: hipFuncSetAttribute failed\n"); grid = -1; return; }
        if (hipOccupancyMaxActiveBlocksPerMultiprocessor(&per_cu, (const void*)mk_fwd, NWAVES * 64, LDS_BYTES) != hipSuccess || per_cu < 1) fprintf(stderr, "kernel_launch: occupancy query reports %d workgroups per CU\n", per_cu);
        (void)hipGetLastError();
        grid = cus;
        if (grid != 256) fprintf(stderr, "kernel_launch: %d CUs; this kernel's unit orders are built for 256\n", grid);
#if FAST_K < 11
        (void)hipFuncSetAttribute((const void*)nv::nv_ffn<true>, hipFuncAttributeMaxDynamicSharedMemorySize, 160 * 1024);
        (void)hipFuncSetAttribute((const void*)nv::nv_mixin, hipFuncAttributeMaxDynamicSharedMemorySize, 160 * 1024);
        (void)hipFuncSetAttribute((const void*)nv::nv_proj<0>, hipFuncAttributeMaxDynamicSharedMemorySize, 160 * 1024);
        (void)hipFuncSetAttribute((const void*)nv::nv_proj<1>, hipFuncAttributeMaxDynamicSharedMemorySize, 160 * 1024);
        (void)hipFuncSetAttribute((const void*)nv::nv_cq, hipFuncAttributeMaxDynamicSharedMemorySize, 160 * 1024);
        (void)hipFuncSetAttribute((const void*)nv::nv_kvmem, hipFuncAttributeMaxDynamicSharedMemorySize, 160 * 1024);
#endif
    }
    if (grid < 0) return;
    unsigned char* ws = (unsigned char*)d_ws;
    (void)hipMemsetAsync(ws + WS_CTL, 0, CTL_ZERO_BYTES, stream);
    Args a{};
    for (int i = 0; i < 26; ++i) a.in[i] = (const float*)d_in[i];
    a.out = (float*)d_out; a.ws = ws; a.ph_lo = 0; a.ph_hi = FAST_K; a.li = 0;
    hipLaunchKernelGGL(mk_fwd, dim3(grid), dim3(NWAVES * 64), LDS_BYTES, stream, a);
#if defined(PROBE_PASSES) && PROBE_PASSES > 1
    (void)hipMemsetAsync(ws + WS_CTL, 0, CTL_ZERO_BYTES, stream); hipLaunchKernelGGL(mk_fwd, dim3(grid), dim3(NWAVES * 64), LDS_BYTES, stream, a);
#endif
#if defined(PROBE_DUP) && PROBE_DUP >= 0
    (void)hipMemsetAsync(ws + WS_CTL, 0, CTL_ZERO_BYTES, stream);
    { Args b = a; b.ph_lo = PROBE_DUP; b.ph_hi = PROBE_DUP + 1; b.li = 1; b.pad = 1; hipLaunchKernelGGL(mk_fwd, dim3(grid), dim3(NWAVES * 64), LDS_BYTES, stream, b); }
#endif
#if FAST_K < 11
    {
        using namespace nv;
        const float* const* in = a.in; float* out = a.out;
        float* ssb = (float*)(ws + SS_OFF); float *ss2 = ssb, *ssv = ssb + M, *ssa = ssb + 2 * M, *ssg = ssb + 3 * M, *ss3 = ssb + 4 * M, *ss4 = ssb + 5 * M;
        nv::bf16_t* XN = (nv::bf16_t*)(ws + WS_XN); nv::bf16_t* MN = (nv::bf16_t*)(ws + WS_MN); nv::bf16_t* KC = (nv::bf16_t*)(ws + WS_KC); nv::bf16_t* VT = (nv::bf16_t*)(ws + WS_VT);
        float* LOGF = (float*)(ws + WS_LOGF); float* CUM = (float*)(ws + WS_CUM); nv::bf16_t* Y = (nv::bf16_t*)(ws + WS_Y);
        nv::bf16_t *Q = (nv::bf16_t*)(ws + WS_Q), *K = (nv::bf16_t*)(ws + WS_K), *V = (nv::bf16_t*)(ws + WS_V), *U = (nv::bf16_t*)(ws + WS_U), *VG = (nv::bf16_t*)(ws + WS_VG), *QC = (nv::bf16_t*)(ws + WS_QC), *OC = (nv::bf16_t*)(ws + WS_OC);
        if (FAST_K <= 3) { nv_kvmem<<<1024 / 8, 256, (8 * 1024 + 8 * 2048) * 4, stream>>>(MN, in[19], in[21], KC, VT);
                           nv_mixin<<<M / 8, 256, (8 * 1024 + 8 * INC) * 4, stream>>>(XN, ss2, in[6], in[7], in[8], in[9], Q, K, V, U, VG, ssv, LOGF); }
        if (FAST_K <= 4) { nv_scan<<<32, 64, 0, stream>>>(LOGF, CUM); nv_fox<<<dim3(64, 32), 64, 0, stream>>>(Q, K, V, CUM, in[13], Y, ssa);
                           nv_sgu<<<1024, 256, 0, stream>>>(U, VG, ssv, in[10], in[11], in[12], in[14], Y, ssg); }
        if (FAST_K <= 5) nv_proj<0><<<M / 8, 256, (16 * 1024) * 4, stream>>>(Y, ssa, ssg, in[15], out, in[16], XN, ss3);
        if (FAST_K <= 6) nv_cq<<<M / 8, 256, (16 * 1024) * 4, stream>>>(XN, ss3, in[18], in[20], QC);
        if (FAST_K <= 7) nv_xattn<<<M, 256, 0, stream>>>(QC, KC, VT, OC);
        if (FAST_K <= 8) nv_proj<1><<<M / 8, 256, (16 * 1024) * 4, stream>>>(OC, nullptr, nullptr, in[22], out, in[23], XN, ss4);
        if (FAST_K <= 10) nv_ffn<true><<<M / 8, 256, (8 * 1024 + 8 * FF) * 4, stream>>>(XN, ss4, out, in[24], in[25], out, nullptr, nullptr, nullptr);
    }
#endif
}
```
